# Optimizing an MI355X kernel written in HIP

```python
import jax, jax.numpy as jnp
from jax import lax
import numpy as np

D_MODEL = 1024
BATCH = 4
SEQ = 4096
DEPTH = 1
DEC_BATCH = 4
DEC_SEQ = 8192
PAST_LEN = 128

D_INNER = 2 * D_MODEL
D_SSD = D_INNER // 2
D_ATTN = D_INNER - D_SSD
HEAD_DIM = 64
N_ATTN_HEADS = D_ATTN // HEAD_DIM
SSD_HEAD_DIM = 64
N_SSD_HEADS = D_SSD // SSD_HEAD_DIM
SSD_GROUPS = 2
D_STATE = 128
CONV_WIDTH = 5
CHUNK = 128
ROPE_THETA = 10000.0
EPS = 1e-5
DT_MIN = 0.001
DT_MAX = 0.1
DILATED_PATTERNS = ((128, 1), (512, 4), (2048, 16))
D_XBC = D_SSD + 2 * SSD_GROUPS * D_STATE
PROJ_SIZES = (D_ATTN, D_ATTN, D_ATTN, D_ATTN, D_SSD, D_XBC, N_SSD_HEADS, N_SSD_HEADS)
D_PROJ = 4 * D_ATTN + D_SSD + D_XBC + 2 * N_SSD_HEADS

kernel_name = 'hybrid_ssd_dilated_attn_encoder'


def rms_norm(x, g):
    xf = x.astype(jnp.float32)
    xf = xf * lax.rsqrt(jnp.mean(xf * xf, axis=-1, keepdims=True) + EPS)
    return (xf * g.astype(jnp.float32)).astype(x.dtype)


def rotary(t):
    s_len, dh = t.shape[1], t.shape[-1]
    half = dh // 2
    inv = ROPE_THETA ** (-jnp.arange(half, dtype=jnp.float32) * 2.0 / dh)
    ang = jnp.arange(s_len, dtype=jnp.float32)[:, None] * inv[None, :]
    cos = jnp.cos(ang)[None, :, None, :]
    sin = jnp.sin(ang)[None, :, None, :]
    t1, t2 = t[..., :half], t[..., half:]
    return jnp.concatenate([t1 * cos - t2 * sin, t2 * cos + t1 * sin], axis=-1)


def dilated_window_attention(q, k, v, window, dilation):
    b, s_len, h, dh = q.shape
    r = window // (2 * dilation)
    l_sub = s_len // dilation
    n = b * dilation

    def to_sub(t):
        return t.reshape(b, l_sub, dilation, h, dh).transpose(0, 2, 1, 3, 4).reshape(n, l_sub, h, dh)

    qs, ks, vs = to_sub(q), to_sub(k), to_sub(v)
    nb = -(-l_sub // r)
    lp = nb * r
    qb = jnp.pad(qs, ((0, 0), (0, lp - l_sub), (0, 0), (0, 0))).reshape(n, nb, r, h, dh)
    kpad = ((0, 0), (r, lp - l_sub + r), (0, 0), (0, 0))
    kp = jnp.pad(ks, kpad).reshape(n, nb + 2, r, h, dh)
    vp = jnp.pad(vs, kpad).reshape(n, nb + 2, r, h, dh)
    kw = jnp.concatenate([kp[:, :-2], kp[:, 1:-1], kp[:, 2:]], axis=2)
    vw = jnp.concatenate([vp[:, :-2], vp[:, 1:-1], vp[:, 2:]], axis=2)
    scores = jnp.einsum('nbqhd,nbkhd->nbhqk', qb, kw) * (HEAD_DIM ** -0.5)
    qi = jnp.arange(nb)[:, None] * r + jnp.arange(r)[None, :]
    ki = jnp.arange(nb)[:, None] * r - r + jnp.arange(3 * r)[None, :]
    valid = ((jnp.abs(qi[:, :, None] - ki[:, None, :]) <= r)
             & (ki[:, None, :] >= 0) & (ki[:, None, :] < l_sub))
    scores = jnp.where(valid[None, :, None], scores, -jnp.inf)
    lse = jax.nn.logsumexp(scores, axis=-1)
    p = jnp.exp(scores - lse[..., None])
    o = jnp.einsum('nbhqk,nbkhd->nbqhd', p, vw)
    o = o.reshape(n, lp, h, dh)[:, :l_sub]
    lse = lse.transpose(0, 1, 3, 2).reshape(n, lp, h)[:, :l_sub]
    o = o.reshape(b, dilation, l_sub, h, dh).transpose(0, 2, 1, 3, 4).reshape(b, s_len, h, dh)
    lse = lse.reshape(b, dilation, l_sub, h).transpose(0, 2, 1, 3).reshape(b, s_len, h)
    return o, lse


def dilated_mixture(q, k, v):
    outs, lses = [], []
    for window, dilation in DILATED_PATTERNS:
        o, lse = dilated_window_attention(q, k, v, window, dilation)
        outs.append(o)
        lses.append(lse)
    w = jax.nn.softmax(jnp.stack(lses, axis=0), axis=0)
    return jnp.sum(w[..., None] * jnp.stack(outs, axis=0), axis=0)


def depthwise_conv_centered(u, w, bias):
    pad = (CONV_WIDTH - 1) // 2
    out = lax.conv_general_dilated(u, w[:, None, :], window_strides=(1,), padding=[(pad, pad)],
                                   dimension_numbers=('NWC', 'WIO', 'NWC'),
                                   feature_group_count=u.shape[-1])
    return out + bias


def ssd_scan(x, dt_raw, b_mat, c_mat, a_log, dt_bias):
    bsz, s_len, h, p = x.shape
    g, nst = b_mat.shape[2], b_mat.shape[3]
    e = h // g
    nc = s_len // CHUNK
    dt = jax.nn.softplus(dt_raw + dt_bias)
    a = dt * (-jnp.exp(a_log))
    xc = (x * dt[..., None]).reshape(bsz, nc, CHUNK, g, e, p)
    ac = a.reshape(bsz, nc, CHUNK, g, e)
    bc = b_mat.reshape(bsz, nc, CHUNK, g, nst)
    cc = c_mat.reshape(bsz, nc, CHUNK, g, nst)
    acum = jnp.cumsum(ac, axis=2)
    seg = acum[:, :, :, None] - acum[:, :, None, :]
    tril = jnp.tril(jnp.ones((CHUNK, CHUNK), dtype=bool))[:, :, None, None]
    lmat = jnp.exp(jnp.where(tril, seg, -jnp.inf))
    cb = jnp.einsum('bclgn,bcsgn->bclsg', cc, bc)
    y_diag = jnp.einsum('bclsge,bcsgep->bclgep', cb[..., None] * lmat, xc)
    decay_to_end = jnp.exp(acum[:, :, -1:] - acum)
    states = jnp.einsum('bcsgn,bcsgep->bcgepn', bc, decay_to_end[..., None] * xc)
    chunk_decay = jnp.exp(acum[:, :, -1])

    def step(carry, inp):
        st, dec = inp
        return carry * dec[..., None, None] + st, carry

    init = jnp.zeros((bsz, g, e, p, nst), dtype=x.dtype)
    _, states_in = lax.scan(step, init, (jnp.moveaxis(states, 1, 0), jnp.moveaxis(chunk_decay, 1, 0)))
    states_in = jnp.moveaxis(states_in, 0, 1)
    y_off = jnp.einsum('bclgn,bcgepn->bclgep', cc, states_in) * jnp.exp(acum)[..., None]
    return (y_diag + y_off).reshape(bsz, s_len, h, p)


def ssd_branch(z, xbc, dt_f, dt_b, conv_w, conv_b, dt_bias_fwd, dt_bias_bwd,
               a_log_fwd, a_log_bwd, d_skip, norm_ssd):
    bsz, s_len, _ = z.shape
    f32 = jnp.float32
    xbc = jax.nn.silu(depthwise_conv_centered(xbc.astype(f32), conv_w.astype(f32), conv_b.astype(f32)))
    xs = xbc[..., :D_SSD].reshape(bsz, s_len, N_SSD_HEADS, SSD_HEAD_DIM)
    b_mat = xbc[..., D_SSD:D_SSD + SSD_GROUPS * D_STATE].reshape(bsz, s_len, SSD_GROUPS, D_STATE)
    c_mat = xbc[..., D_SSD + SSD_GROUPS * D_STATE:].reshape(bsz, s_len, SSD_GROUPS, D_STATE)
    y_fwd = ssd_scan(xs, dt_f.astype(f32), b_mat, c_mat, a_log_fwd.astype(f32), dt_bias_fwd.astype(f32))
    fl = lambda t: jnp.flip(t, axis=1)
    y_bwd = fl(ssd_scan(fl(xs), fl(dt_b.astype(f32)), fl(b_mat), fl(c_mat),
                        a_log_bwd.astype(f32), dt_bias_bwd.astype(f32)))
    y = y_fwd + y_bwd + d_skip.astype(f32)[:, None] * xs
    y = y.reshape(bsz, s_len, D_SSD) * jax.nn.silu(z.astype(f32))
    return rms_norm(y, norm_ssd)


def attention_branch(q, k, v, z):
    bsz, s_len, _ = q.shape
    f32 = jnp.float32
    shp = (bsz, s_len, N_ATTN_HEADS, HEAD_DIM)
    qh = rotary(q.astype(f32).reshape(shp))
    kh = rotary(k.astype(f32).reshape(shp))
    vh = v.astype(f32).reshape(shp)
    o = dilated_mixture(qh, kh, vh).reshape(bsz, s_len, D_ATTN)
    return o * jax.nn.silu(z.astype(f32))


def encoder(x, w_in, conv_w, conv_b, dt_bias_fwd, dt_bias_bwd, a_log_fwd, a_log_bwd,
            d_skip, norm_ssd, norm_in, w_out, norm_f):
    split_at = [int(i) for i in np.cumsum(PROJ_SIZES)[:-1]]
    for layer in range(DEPTH):
        h = rms_norm(x, norm_in[layer])
        proj = h @ w_in[layer]
        q, k, v, z_attn, z_ssd, xbc, dt_f, dt_b = jnp.split(proj, split_at, axis=-1)
        y_ssd = ssd_branch(z_ssd, xbc, dt_f, dt_b, conv_w[layer], conv_b[layer],
                           dt_bias_fwd[layer], dt_bias_bwd[layer], a_log_fwd[layer],
                           a_log_bwd[layer], d_skip[layer], norm_ssd[layer])
        y_attn = attention_branch(q, k, v, z_attn)
        mix = jnp.concatenate([y_ssd.astype(x.dtype), y_attn.astype(x.dtype)], axis=-1)
        x = x + mix @ w_out[layer]
    return rms_norm(x, norm_f)


def setup_inputs(seed: int = 0) -> dict:
    key = jax.random.key(seed)
    ks = jax.random.split(key, 16)
    f32 = jnp.float32
    x_prompt = jax.random.normal(ks[0], (BATCH, SEQ, D_MODEL), f32)
    x_sample = jax.random.normal(ks[1], (DEC_BATCH, DEC_SEQ, D_MODEL), f32)
    w_in = jax.random.normal(ks[2], (DEPTH, D_MODEL, D_PROJ), f32) * D_MODEL ** -0.5
    conv_w = jax.random.normal(ks[3], (DEPTH, CONV_WIDTH, D_XBC), f32) * CONV_WIDTH ** -0.5
    conv_b = jax.random.normal(ks[4], (DEPTH, D_XBC), f32) * 0.02

    def dt_bias_init(k):
        u = jax.random.uniform(k, (DEPTH, N_SSD_HEADS), f32)
        dt = jnp.exp(u * (jnp.log(DT_MAX) - jnp.log(DT_MIN)) + jnp.log(DT_MIN))
        return dt + jnp.log(-jnp.expm1(-dt))

    dt_bias_fwd = dt_bias_init(ks[5])
    dt_bias_bwd = dt_bias_init(ks[6])
    a_log_fwd = jnp.log(jax.random.uniform(ks[7], (DEPTH, N_SSD_HEADS), f32, minval=1.0, maxval=16.0))
    a_log_bwd = jnp.log(jax.random.uniform(ks[8], (DEPTH, N_SSD_HEADS), f32, minval=1.0, maxval=16.0))
    d_skip = 1.0 + 0.1 * jax.random.normal(ks[9], (DEPTH, N_SSD_HEADS), f32)
    norm_ssd = 1.0 + 0.02 * jax.random.normal(ks[10], (DEPTH, D_SSD), f32)
    norm_in = 1.0 + 0.02 * jax.random.normal(ks[11], (DEPTH, D_MODEL), f32)
    w_out = jax.random.normal(ks[12], (DEPTH, D_INNER, D_MODEL), f32) * D_INNER ** -0.5
    norm_f = 1.0 + 0.02 * jax.random.normal(ks[13], (D_MODEL,), f32)
    return {'x_prompt': x_prompt, 'x_sample': x_sample, 'w_in': w_in, 'conv_w': conv_w,
            'conv_b': conv_b, 'dt_bias_fwd': dt_bias_fwd, 'dt_bias_bwd': dt_bias_bwd,
            'a_log_fwd': a_log_fwd, 'a_log_bwd': a_log_bwd, 'd_skip': d_skip,
            'norm_ssd': norm_ssd, 'norm_in': norm_in, 'w_out': w_out, 'norm_f': norm_f}


def reference(x_prompt, x_sample, w_in, conv_w, conv_b, dt_bias_fwd, dt_bias_bwd,
              a_log_fwd, a_log_bwd, d_skip, norm_ssd, norm_in, w_out, norm_f):
    y_prompt = encoder(x_prompt, w_in, conv_w, conv_b, dt_bias_fwd, dt_bias_bwd, a_log_fwd,
                       a_log_bwd, d_skip, norm_ssd, norm_in, w_out, norm_f)
    y_sample = encoder(x_sample, w_in, conv_w, conv_b, dt_bias_fwd, dt_bias_bwd, a_log_fwd,
                       a_log_bwd, d_skip, norm_ssd, norm_in, w_out, norm_f)
    return (y_prompt, y_sample)
```

```cpp
#include <hip/hip_runtime.h>
#include <cstdio>
#include <cstdint>
#include <cmath>
namespace pg8 {
#define PG8_LAS __attribute__((address_space(3)))
typedef unsigned short bf16_t;
typedef short bf16x8 __attribute__((ext_vector_type(8)));
typedef float f32x4 __attribute__((ext_vector_type(4)));
typedef unsigned u32x4 __attribute__((ext_vector_type(4)));
constexpr int BM = 256, BK = 64, HALF = 128, HTB = HALF * BK * 2  , STAGE_BYTES = 8 * HTB, NXCD = 8, WGM = 8;

__host__ __device__ __forceinline__ int lds_byte(int r, int c) { const int st = (r >> 4) * 2 + (c >> 5), rr = r & 15, cc = c & 31, ob = rr * 64 + cc * 2; return st * 1024 + (ob ^ (((ob >> 9) & 1) << 5)); }
__host__ __device__ __forceinline__ void stage_rc(int b, int& R, int& C) { const int st = b / 1024, sb = b % 1024, swz = sb ^ (((sb >> 9) & 1) << 5); R = (st >> 1) * 16 + swz / 64; C = (st & 1) * 32 + (swz % 64) / 2; }
__host__ __device__ __forceinline__ int perm32(int rho) { const int n = rho >> 4, i = rho & 15; return 8 * (i >> 2) + 4 * n + (i & 3); }

struct Unit { int pm, pn; };
struct Gemm { const bf16_t* A; const bf16_t* Bt; int M, N, K; };

struct StaticOrder {
    int nM, nN, nwg, G, c;
    __host__ __device__ void init(int M, int N, int G_, int c_) { nM = M / BM; nN = N / BM; nwg = nM * nN; G = G_; c = c_; }
    __host__ __device__ bool next(int i, Unit& u) const {
        const long L = (long)i * G + c; if (L >= nwg) return false;
        int wgid = (int)L; { const int q = nwg / NXCD, r = nwg % NXCD, xcd = wgid % NXCD, off = wgid / NXCD; wgid = (xcd < r ? xcd * (q + 1) : r * (q + 1) + (xcd - r) * q) + off; }
        const int nig = WGM * nN, gid = wgid / nig, fm = gid * WGM, gsz = (nM - fm) < WGM ? (nM - fm) : WGM;
        u.pm = fm + ((wgid % nig) % gsz); u.pn = (wgid % nig) / gsz; return true;
    }
    __device__ __forceinline__ void a_ready(const Unit&) const {}
    __device__ __forceinline__ void done(const Unit&) const {}
};

__device__ __forceinline__ unsigned cvt_pk_bf16(float lo, float hi) { unsigned r; asm volatile("v_cvt_pk_bf16_f32 %0, %1, %2" : "=v"(r) : "v"(lo), "v"(hi)); return r; }
typedef float f32x2 __attribute__((ext_vector_type(2)));
__device__ __forceinline__ f32x2 gelu_pk(f32x2 v) {
    const f32x2 av = __builtin_elementwise_abs(v), d = av * 0.2316418882f + 1.0f;
    f32x2 t; t.x = __builtin_amdgcn_rcpf(d.x); t.y = __builtin_amdgcn_rcpf(d.y);
    f32x2 q = t * 0.5307027145f + (-0.7265760135f); q = q * t + 0.7107068705f; q = q * t + (-0.142248368f); q = q * t + 0.127414796f; q = q * t;
    const f32x2 s = (v * v) * (-0.72134752044f);
    f32x2 e; e.x = __builtin_amdgcn_exp2f(s.x); e.y = __builtin_amdgcn_exp2f(s.y);
    const f32x2 m = v * (q * e), r = v - m;
    f32x2 o; o.x = v.x < 0.f ? m.x : r.x; o.y = v.y < 0.f ? m.y : r.y; return o;
}

struct EpiInProj {
    static constexpr bool PERM = true, AFTER_DRAIN = false;
    bf16_t *MIX, *KB, *VB, *ZA, *XS, *BCR; float* DT; const float* rope;
    __device__ __forceinline__ void operator()(const f32x4 (&acc)[2][2][4][2], const Unit& u, int wr, int wc, int fr, int fq) const {
        const int row0 = u.pm * BM + wr * 64 + fr; const int pn = u.pn;
        if (pn == 26) {
            if (wc == 0) {
#pragma unroll
                for (int ai = 0; ai < 2; ++ai)
#pragma unroll
                    for (int m = 0; m < 4; ++m) { float* rp = DT + (size_t)(row0 + ai * HALF + m * 16) * 32 + 8 * fq;
                        *(f32x4*)rp = acc[ai][0][m][0]; *(f32x4*)(rp + 4) = acc[ai][0][m][1]; }
            }
            return;
        }
        bf16_t* base; int ldc, colt, mode = 0;
        if (pn < 4)       { base = MIX + 1024; ldc = 2048; colt = pn * 256; mode = 1; }
        else if (pn < 8)  { base = KB;  ldc = 1024; colt = (pn - 4) * 256; mode = 2; }
        else if (pn < 12) { base = VB;  ldc = 1024; colt = (pn - 8) * 256; }
        else if (pn < 16) { base = ZA;  ldc = 1024; colt = (pn - 12) * 256; }
        else if (pn < 20) { base = MIX; ldc = 2048; colt = (pn - 16) * 256; }
        else if (pn < 24) { base = XS;  ldc = 1024; colt = (pn - 20) * 256; }
        else              { base = BCR; ldc = 512;  colt = (pn - 24) * 256; }
        const int col0 = colt + wc * 32 + 8 * fq;
        const float qs = (mode == 1) ? 0.125f * 1.4426950408889634f : 1.0f;
        const int j0 = (wc & 1) * 16 + 4 * fq;
#pragma unroll
        for (int ai = 0; ai < 2; ++ai)
#pragma unroll
            for (int m = 0; m < 4; ++m) {
                const int row = row0 + ai * HALF + m * 16;
                bf16_t* rowp = base + (size_t)row * ldc + col0;
                f32x4 cs0 = {1.f, 0.f, 1.f, 0.f}, cs1 = {1.f, 0.f, 1.f, 0.f};
                if (mode != 0) { const int pos = row < 16384 ? (row & 4095) : ((row - 16384) & 8191);
                    const float* rp = rope + ((size_t)pos * 32 + j0) * 2; cs0 = *(const f32x4*)rp; cs1 = *(const f32x4*)(rp + 4); }
#pragma unroll
                for (int bj = 0; bj < 2; ++bj) {
                    f32x4 v0 = acc[ai][bj][m][0], v1 = acc[ai][bj][m][1];
                    if (mode != 0) {
                        f32x4 a, b;
                        a[0] = v0[0] * cs0[0] - v0[1] * cs0[1]; a[1] = v0[1] * cs0[0] + v0[0] * cs0[1];
                        a[2] = v0[2] * cs0[2] - v0[3] * cs0[3]; a[3] = v0[3] * cs0[2] + v0[2] * cs0[3];
                        b[0] = v1[0] * cs1[0] - v1[1] * cs1[1]; b[1] = v1[1] * cs1[0] + v1[0] * cs1[1];
                        b[2] = v1[2] * cs1[2] - v1[3] * cs1[3]; b[3] = v1[3] * cs1[2] + v1[2] * cs1[3];
                        v0 = a * qs; v1 = b * qs;
                    }
                    u32x4 w; w.x = cvt_pk_bf16(v0[0], v0[1]); w.y = cvt_pk_bf16(v0[2], v0[3]); w.z = cvt_pk_bf16(v1[0], v1[1]); w.w = cvt_pk_bf16(v1[2], v1[3]);
                    *(u32x4*)(rowp + bj * HALF) = w;
                }
            }
    }
};
struct EpiOutProj {
    static constexpr bool PERM = false, AFTER_DRAIN = false;
    const float* xp; const float* xs; float* out; float* ssq;
    __device__ __forceinline__ void operator()(const f32x4 (&acc)[2][2][4][2], const Unit& u, int wr, int wc, int fr, int fq) const {
        const int row0 = u.pm * BM + wr * 64 + fr; const int col0 = u.pn * BM + wc * 32 + 4 * fq;
#pragma unroll
        for (int ai = 0; ai < 2; ++ai)
#pragma unroll
            for (int m = 0; m < 4; ++m) {
                const int row = row0 + ai * HALF + m * 16;
                const float* xr = (row < 16384 ? xp + (size_t)row * 1024 : xs + (size_t)(row - 16384) * 1024) + col0;
                float* orow = out + (size_t)row * 1024 + col0; float s = 0.f;
#pragma unroll
                for (int bj = 0; bj < 2; ++bj)
#pragma unroll
                    for (int n = 0; n < 2; ++n) { const f32x4 o = *(const f32x4*)(xr + bj * HALF + n * 16) + acc[ai][bj][m][n];
                        *(f32x4*)(orow + bj * HALF + n * 16) = o; s += (o[0] * o[0] + o[1] * o[1]) + (o[2] * o[2] + o[3] * o[3]); }
                s += __shfl_xor(s, 16); s += __shfl_xor(s, 32);
                if (fq == 0) atomicAdd(ssq + row, s);
            }
    }
};
template <class Epi, class Sched, bool ALIGN_EPI = false, bool SP2 = false>
__device__ __forceinline__ void gemm_phase(PG8_LAS unsigned char* lds, const Gemm g, const Sched& S, const Epi& E) {
    const int tid = threadIdx.x, wid = __builtin_amdgcn_readfirstlane(tid >> 6), lane = tid & 63, wr = wid >> 2, wc = wid & 3, fr = lane & 15, fq = lane >> 4;
    const int K = g.K, nt = K / BK;
    unsigned voffA[2], voffB[2];
#pragma unroll
    for (int i = 0; i < 2; ++i) { int R, C; stage_rc(tid * 16 + i * 8192, R, C); const int Rb = Epi::PERM ? ((R & ~31) + perm32(R & 31)) : R;
        voffA[i] = (unsigned)(R * K + C) * 2u; voffB[i] = (unsigned)(Rb * K + C) * 2u; }
    const size_t kstep = (size_t)(BK * 2);
    const size_t hstep = (size_t)HALF * K * 2;
    const size_t tstep = 2 * hstep;
    const unsigned ldsw = (unsigned)wid * 1024u;
    const int aoff = lds_byte(wr * 64 + fr, fq * 8), boff = lds_byte(wc * 32 + fr, fq * 8);
#define PG8_SA(b, h) (((b) * 2 + (h)) * HTB)
#define PG8_SB(b, h) ((4 + (b) * 2 + (h)) * HTB)
#define PG8_STAGE(bufoff, gbase, voff) do { _Pragma("unroll") for (int _i = 0; _i < 2; ++_i) \
        __builtin_amdgcn_global_load_lds((const unsigned*)((const char*)(gbase) + (voff)[_i]), (PG8_LAS unsigned*)(lds + (bufoff) + ldsw + _i * 8192), 16, 0, 0); } while (0)
#define PG8_LDA(dst, b, h) do { _Pragma("unroll") for (int m = 0; m < 4; ++m) _Pragma("unroll") for (int k = 0; k < 2; ++k) dst[m][k] = *(const PG8_LAS bf16x8*)(lds + PG8_SA(b, h) + aoff + m * 2048 + k * 1024); } while (0)
#define PG8_LDB(dst, b, h) do { _Pragma("unroll") for (int n = 0; n < 2; ++n) _Pragma("unroll") for (int k = 0; k < 2; ++k) dst[n][k] = *(const PG8_LAS bf16x8*)(lds + PG8_SB(b, h) + boff + n * 2048 + k * 1024); } while (0)
#define PG8_MMA(ai, bj, At, Bt) do { __builtin_amdgcn_s_setprio(1); _Pragma("unroll") for (int m = 0; m < 4; ++m) _Pragma("unroll") for (int n = 0; n < 2; ++n) _Pragma("unroll") for (int k = 0; k < 2; ++k) \
        acc[ai][bj][m][n] = __builtin_amdgcn_mfma_f32_16x16x32_bf16(Bt[n][k], At[m][k], acc[ai][bj][m][n], 0, 0, 0); __builtin_amdgcn_s_setprio(0); } while (0)
#define PG8_WAIT_V(n) asm volatile("s_waitcnt vmcnt(" #n ")" ::: "memory")
#define PG8_WAIT_L(n) asm volatile("s_waitcnt lgkmcnt(" #n ")" ::: "memory")
#define PG8_BAR __builtin_amdgcn_s_barrier()
#define PG8_SCHED __builtin_amdgcn_sched_barrier(0)
    Unit cur, nxt; int ui = 0;
    if (!S.next(0, cur)) return;
    f32x4 acc[2][2][4][2];
#pragma unroll
    for (int a = 0; a < 2; ++a)
#pragma unroll
        for (int b = 0; b < 2; ++b)
#pragma unroll
            for (int m = 0; m < 4; ++m)
#pragma unroll
                for (int n = 0; n < 2; ++n) acc[a][b][m][n] = (f32x4){0.f, 0.f, 0.f, 0.f};
    bf16x8 At[4][2], B0[2][2], B1[2][2];
    const char* cA = (const char*)g.A + (size_t)cur.pm * tstep; const char* cB = (const char*)g.Bt + (size_t)cur.pn * tstep;
    S.a_ready(cur);
    if constexpr (SP2) {
        PG8_STAGE(PG8_SB(0, 0), cB, voffB); PG8_STAGE(PG8_SB(0, 1), cB + hstep, voffB); PG8_STAGE(PG8_SA(0, 0), cA, voffA); PG8_STAGE(PG8_SA(0, 1), cA + hstep, voffA);
        if (wr == 1) PG8_BAR;
        PG8_WAIT_V(2); PG8_BAR;
        PG8_STAGE(PG8_SB(1, 0), cB + kstep, voffB); PG8_STAGE(PG8_SA(1, 0), cA + kstep, voffA); PG8_STAGE(PG8_SB(1, 1), cB + hstep + kstep, voffB);
        PG8_WAIT_V(6); PG8_BAR;
    } else {
        PG8_STAGE(PG8_SB(0, 0), cB, voffB); PG8_STAGE(PG8_SA(0, 0), cA, voffA); PG8_STAGE(PG8_SB(0, 1), cB + hstep, voffB); PG8_STAGE(PG8_SA(0, 1), cA + hstep, voffA);
        if (wr == 1) PG8_BAR;
        PG8_WAIT_V(4); PG8_BAR;
        PG8_STAGE(PG8_SB(1, 0), cB + kstep, voffB); PG8_STAGE(PG8_SA(1, 0), cA + kstep, voffA); PG8_STAGE(PG8_SB(1, 1), cB + hstep + kstep, voffB);
        PG8_WAIT_V(6); PG8_BAR;
    }
    for (;;) {
        const bool has_next = S.next(ui + 1, nxt);
        const char* nA = has_next ? (const char*)g.A + (size_t)nxt.pm * tstep : cA; const char* nB = has_next ? (const char*)g.Bt + (size_t)nxt.pn * tstep : cB;
        for (int t = 0; t < nt; t += 2) {
            const bool last = (t == nt - 2);
            const char* a1 = cA + (size_t)(t + 1) * kstep;
            const char* a2 = last ? nA : cA + (size_t)(t + 2) * kstep; const char* b2 = last ? nB : cB + (size_t)(t + 2) * kstep;
            const char* a3 = a2 + kstep; const char* b3 = b2 + kstep;
            if (last && has_next) S.a_ready(nxt);
            if constexpr (SP2) {
            PG8_LDB(B0, 0, 0); PG8_LDB(B1, 0, 1); PG8_SCHED; PG8_LDA(At, 0, 0); PG8_STAGE(PG8_SA(1, 1), a1 + hstep, voffA);
            PG8_WAIT_V(8); PG8_WAIT_L(0); PG8_BAR; PG8_MMA(0, 0, At, B0); PG8_MMA(0, 1, At, B1); PG8_BAR; PG8_SCHED;
            PG8_LDA(At, 0, 1); PG8_STAGE(PG8_SB(0, 0), b2, voffB); PG8_STAGE(PG8_SB(0, 1), b2 + hstep, voffB); PG8_STAGE(PG8_SA(0, 0), a2, voffA);
            PG8_WAIT_V(8); PG8_WAIT_L(0); PG8_BAR; PG8_MMA(1, 0, At, B0); PG8_MMA(1, 1, At, B1); PG8_BAR; PG8_SCHED;
            PG8_LDB(B0, 1, 0); PG8_LDB(B1, 1, 1); PG8_SCHED; PG8_LDA(At, 1, 0); PG8_STAGE(PG8_SA(0, 1), a2 + hstep, voffA);
            PG8_WAIT_V(8); PG8_WAIT_L(0); PG8_BAR; PG8_MMA(0, 0, At, B0); PG8_MMA(0, 1, At, B1); PG8_BAR; PG8_SCHED;
            PG8_LDA(At, 1, 1); PG8_STAGE(PG8_SB(1, 0), b3, voffB); PG8_STAGE(PG8_SB(1, 1), b3 + hstep, voffB); PG8_STAGE(PG8_SA(1, 0), a3, voffA);
            PG8_WAIT_V(8); PG8_WAIT_L(0); PG8_BAR; PG8_MMA(1, 0, At, B0); PG8_MMA(1, 1, At, B1); PG8_BAR; PG8_SCHED;
            } else {
            PG8_LDB(B0, 0, 0); PG8_SCHED; PG8_LDA(At, 0, 0); PG8_STAGE(PG8_SA(1, 1), a1 + hstep, voffA);
            PG8_WAIT_L(8); PG8_BAR; PG8_WAIT_L(0); PG8_MMA(0, 0, At, B0); PG8_BAR; PG8_SCHED;
            PG8_LDB(B1, 0, 1); PG8_STAGE(PG8_SB(0, 0), b2, voffB);
            PG8_BAR; PG8_WAIT_L(0); PG8_MMA(0, 1, At, B1); PG8_BAR;
            PG8_LDA(At, 0, 1); PG8_STAGE(PG8_SA(0, 0), a2, voffA);
            PG8_BAR; PG8_WAIT_L(0); PG8_MMA(1, 0, At, B0); PG8_BAR; PG8_SCHED;
            PG8_STAGE(PG8_SB(0, 1), b2 + hstep, voffB);
            PG8_WAIT_V(6); PG8_BAR; PG8_MMA(1, 1, At, B1); PG8_BAR;
            PG8_LDB(B0, 1, 0); PG8_SCHED; PG8_LDA(At, 1, 0); PG8_STAGE(PG8_SA(0, 1), a2 + hstep, voffA);
            PG8_WAIT_L(8); PG8_BAR; PG8_WAIT_L(0); PG8_MMA(0, 0, At, B0); PG8_BAR; PG8_SCHED;
            PG8_LDB(B1, 1, 1); PG8_STAGE(PG8_SB(1, 0), b3, voffB);
            PG8_BAR; PG8_WAIT_L(0); PG8_MMA(0, 1, At, B1); PG8_BAR;
            PG8_LDA(At, 1, 1); PG8_STAGE(PG8_SA(1, 0), a3, voffA);
            PG8_BAR; PG8_WAIT_L(0); PG8_MMA(1, 0, At, B0); PG8_BAR; PG8_SCHED;
            PG8_STAGE(PG8_SB(1, 1), b3 + hstep, voffB);
            PG8_WAIT_V(6); PG8_BAR; PG8_MMA(1, 1, At, B1); PG8_BAR;
            }
        }
        if constexpr (ALIGN_EPI) { if (wr == 0) PG8_BAR; }
        if constexpr (!Epi::AFTER_DRAIN) { E(acc, cur, wr, wc, fr, fq); S.done(cur); }
        if (!has_next) break;
#pragma unroll
        for (int a = 0; a < 2; ++a)
#pragma unroll
            for (int b = 0; b < 2; ++b)
#pragma unroll
                for (int m = 0; m < 4; ++m)
#pragma unroll
                    for (int n = 0; n < 2; ++n) acc[a][b][m][n] = (f32x4){0.f, 0.f, 0.f, 0.f};
        cur = nxt; cA = nA; cB = nB; ++ui;
        if constexpr (ALIGN_EPI) { if (wr == 1) PG8_BAR; }
    }
    PG8_WAIT_V(0);
    if constexpr (!ALIGN_EPI) { if (wr == 0) PG8_BAR; }
    PG8_BAR;
    if constexpr (Epi::AFTER_DRAIN) { E.fused(acc, cur, wr, wc, fr, fq, lds, wid, lane); S.done(cur); }
#undef PG8_SA
#undef PG8_SB
#undef PG8_STAGE
#undef PG8_LDA
#undef PG8_LDB
#undef PG8_MMA
#undef PG8_WAIT_V
#undef PG8_WAIT_L
#undef PG8_BAR
#undef PG8_SCHED
}
}
constexpr int NWAVES = 8, NT = NWAVES * 64;
constexpr int DM = 1024, M_P = 4 * 4096, M_S = 4 * 8192, M = M_P + M_S;
constexpr int NPROJ = 6688, NPAD = 6912, KOUT = 2048;
constexpr float EPS = 1e-5f;
constexpr size_t MiB = 1u << 20;
constexpr size_t WS_CTL = 0, CTL_ZERO_BYTES = 1 * MiB;
constexpr size_t CTL_SSQ_SSD = 256 * 1024, CTL_SSQ_OUT = 512 * 1024;
constexpr size_t WS_WIN = 2 * MiB;
constexpr size_t WS_WOUT = 16 * MiB;
constexpr size_t WS_ROPE = 20 * MiB;
constexpr size_t WS_DT = 22 * MiB;
constexpr size_t WS_MIX = 32 * MiB;
constexpr size_t WS_K = 224 * MiB, WS_V = 320 * MiB, WS_ZA = 416 * MiB, WS_XS = 512 * MiB;
constexpr size_t WS_BCR = 608 * MiB;
constexpr size_t WS_FREE = 656 * MiB;
constexpr size_t WS_END = 768 * MiB;
constexpr int CW_BAR = 4096;
constexpr int RING_OFF = 0, RING_BYTES = 131072;
constexpr int LDSCTL_OFF = RING_BYTES, MISC_OFF = LDSCTL_OFF + 320;
constexpr int LDS_BYTES = 147456;
#define GAS __attribute__((address_space(1)))
#define LAS __attribute__((address_space(3)))
typedef unsigned short bf16;
typedef unsigned v4u __attribute__((ext_vector_type(4)));
typedef unsigned v2u __attribute__((ext_vector_type(2)));
typedef float f32x4 __attribute__((ext_vector_type(4)));
#define LDS_WAIT() asm volatile("s_waitcnt lgkmcnt(0)" ::: "memory")
#define VM_WAIT() asm volatile("s_waitcnt vmcnt(0)" ::: "memory")
__device__ __forceinline__ unsigned f2bf(float f) { unsigned u = __builtin_bit_cast(unsigned, f); return (u + 0x7fffu + ((u >> 16) & 1u)) >> 16; }
__device__ __forceinline__ unsigned pk2(float lo, float hi) { return f2bf(lo) | (f2bf(hi) << 16); }
__device__ __forceinline__ float bf2f(unsigned short b) { return __builtin_bit_cast(float, (unsigned)b << 16); }
__device__ __forceinline__ float bflo(unsigned w) { return __builtin_bit_cast(float, w << 16); }
__device__ __forceinline__ float bfhi(unsigned w) { return __builtin_bit_cast(float, w & 0xffff0000u); }
__device__ __forceinline__ float silu_f(float v) { return v / (1.f + __expf(-v)); }
#define XB_TMO      128
#define XB_XCNT(j)  (256  + 64 * (j))
#define XB_XSUB(j)  (1280 + 64 * (j))
#define XB_XGEN(j)  (2304 + 64 * (j))
#define XB_TOP      3328
#define XB_TOPGEN   3392
#define XCD_BAR_WORDS 3456
#define XB_SPIN_CAP (1u << 18)

__device__ __forceinline__ unsigned xb_ld(unsigned* p)              { return __hip_atomic_load(p, __ATOMIC_RELAXED, __HIP_MEMORY_SCOPE_AGENT); }
__device__ __forceinline__ unsigned xb_add(unsigned* p, unsigned v) { return __hip_atomic_fetch_add(p, v, __ATOMIC_RELAXED, __HIP_MEMORY_SCOPE_AGENT); }
__device__ __forceinline__ unsigned xb_xcc_id() { return (unsigned)__builtin_amdgcn_s_getreg((3 << 11) | 20) & 0xFu; }
#define XB_SPIN(cond, bar) do { unsigned _sp = 0; while (cond) { __builtin_amdgcn_s_sleep(1); \
    if ((++_sp & 255u) == 0u) { if (xb_ld(&(bar)[XB_TMO])) break; if (_sp > XB_SPIN_CAP) { atomicAdd(&(bar)[XB_TMO], 1u); break; } } } } while (0)

struct XcdBarrier {
    unsigned* bar; unsigned x;
    volatile LAS unsigned* st;
};

__device__ __forceinline__ XcdBarrier xcd_barrier_post(unsigned* bar, volatile LAS unsigned* st) {
    XcdBarrier b; b.bar = bar; b.x = xb_xcc_id(); b.st = st;
    if (threadIdx.x == 0) (void)xb_add(&bar[XB_XCNT(b.x)], 1u);
    return b;
}
__device__ __forceinline__ void xcd_barrier_complete(unsigned* bar, unsigned x, unsigned& nloc, unsigned& nx) {
    const unsigned G = gridDim.x * gridDim.y * gridDim.z;
    unsigned sum, cnt, mine, sp = 0u;
    for (;;) {
        sum = 0u; cnt = 0u; mine = 0u;
#pragma unroll
        for (unsigned j = 0; j < 16; ++j) { const unsigned c = xb_ld(&bar[XB_XCNT(j)]); sum += c; cnt += (c > 0u) ? 1u : 0u; mine = (j == x) ? c : mine; }
        if (sum == G) break;
        __builtin_amdgcn_s_sleep(1);
        if ((++sp & 255u) == 0u) { if (xb_ld(&bar[XB_TMO])) break; if (sp > XB_SPIN_CAP) { atomicAdd(&bar[XB_TMO], 1u); break; } }
    }
    nloc = mine > 0u ? mine : 1u; nx = cnt > 0u ? cnt : 1u;
}

__device__ __forceinline__ void xcd_barrier(const XcdBarrier& b) {
    asm volatile("s_waitcnt vmcnt(0)" ::: "memory");
    __syncthreads();
    if (threadIdx.x == 0) {
        unsigned* bar = b.bar;
        __builtin_amdgcn_s_waitcnt(0);
        unsigned nloc = b.st[0], nx = b.st[1];
        if (nloc == 0u) { xcd_barrier_complete(bar, b.x, nloc, nx); b.st[0] = nloc; b.st[1] = nx; }
        const unsigned old = xb_add(&bar[XB_XSUB(b.x)], 1u);
        const unsigned gen = old / nloc;
        if (old + 1u == (gen + 1u) * nloc) {
            __builtin_amdgcn_fence(__ATOMIC_RELEASE, "agent");
            asm volatile("s_waitcnt vmcnt(0)" ::: "memory");
            const unsigned og = xb_add(&bar[XB_TOP], 1u);
            const unsigned tg = og / nx;
            if (og + 1u == (tg + 1u) * nx) xb_add(&bar[XB_TOPGEN], 1u);
            else XB_SPIN(xb_ld(&bar[XB_TOPGEN]) == tg, bar);
            __builtin_amdgcn_fence(__ATOMIC_ACQUIRE, "agent");
            xb_add(&bar[XB_XGEN(b.x)], 1u);
            asm volatile("s_waitcnt vmcnt(0)" ::: "memory");
        } else {
            XB_SPIN(xb_ld(&bar[XB_XGEN(b.x)]) == gen, bar);
            __builtin_amdgcn_fence(__ATOMIC_ACQUIRE, "agent");
            asm volatile("s_waitcnt vmcnt(0)" ::: "memory");
        }
    }
    __syncthreads();
}
struct Args { const float* in[14]; float* out; unsigned char* ws; int ph_lo, ph_hi; };
struct Frame {
    LAS unsigned char* lds; int tid, lane, wave, G, bid;
    const float *xp, *xsm, *w_in, *conv_w, *conv_b, *dtb_f, *dtb_b, *alog_f, *alog_b, *dskip, *norm_ssd, *norm_in, *w_out, *norm_f;
    float* out; unsigned char* ws;
    bf16 *WIN, *WOUT, *MIX, *KB, *VB, *ZA, *XS, *BCR, *XN, *XC, *YF; float *ROPE, *DT, *SSQ_SSD, *SSQ_OUT;
};
__device__ __forceinline__ float wave_sum(float v) {
#pragma unroll
    for (int o = 1; o < 64; o <<= 1) v += __shfl_xor(v, o);
    return v;
}
__device__ __forceinline__ void row_info(int row, int& seq0, int& pos, int& S) {
    if (row < M_P) { S = 4096; pos = row & 4095; seq0 = row & ~4095; } else { const int r = row - M_P; S = 8192; pos = r & 8191; seq0 = M_P + (r & ~8191); }
}
__device__ __forceinline__ int win_dst_row(int s) { if (s < 2048) { const int d = s & 63; return (s & ~63) + (d < 32 ? 2 * d : 2 * (d - 32) + 1); } return s; }
template <bool PERMQ>
__device__ __forceinline__ void transpose_item(const float* W, int K, int N, bf16* WT, const float* kscale, int nscale, LAS float* scr, int item, int lane) {
    const int nblk = N / 32, kb = item / nblk, nb = item % nblk, k0 = 64 * kb, n0 = 32 * nb;
#pragma unroll 8
    for (int i = 0; i < 32; ++i) { const int kk = 2 * i + (lane >> 5); const float sc = (k0 + kk < nscale) ? kscale[k0 + kk] : 1.f;
        scr[kk * 33 + (lane & 31)] = W[(size_t)(k0 + kk) * N + n0 + (lane & 31)] * sc; }
    LDS_WAIT(); asm volatile("" ::: "memory");
    const int c = lane & 7;
#pragma unroll
    for (int j = 0; j < 4; ++j) { const int n = (lane >> 3) + 8 * j; const LAS float* s = scr + (8 * c) * 33 + n;
        v4u o; o.x = pk2(s[0 * 33], s[1 * 33]); o.y = pk2(s[2 * 33], s[3 * 33]); o.z = pk2(s[4 * 33], s[5 * 33]); o.w = pk2(s[6 * 33], s[7 * 33]);
        const int dst = PERMQ ? win_dst_row(n0 + n) : (n0 + n);
        *(GAS v4u*)(WT + (size_t)dst * K + k0 + 8 * c) = o; }
    LDS_WAIT(); asm volatile("" ::: "memory");
}
__device__ __forceinline__ void p0_prologue(Frame& F) {
    LAS float* scr = (LAS float*)(F.lds + RING_OFF + F.wave * 16384);
    const int gw = F.bid * NWAVES + F.wave, NGW = F.G * NWAVES;
    constexpr int I_IN = (DM / 64) * (NPROJ / 32), I_OUT = (KOUT / 64) * (DM / 32);
    for (int it = gw; it < I_IN + I_OUT; it += NGW) {
        if (it < I_IN) transpose_item<true>(F.w_in, DM, NPROJ, F.WIN, F.norm_in, DM, scr, it, F.lane);
        else transpose_item<false>(F.w_out, KOUT, DM, F.WOUT, F.norm_ssd, 1024, scr, it - I_IN, F.lane);
    }
    {
        const int gt = F.bid * NT + F.tid, NGT = F.G * NT; constexpr int NV = (NPAD - NPROJ) * DM / 8;
        GAS v4u* z = (GAS v4u*)(F.WIN + (size_t)NPROJ * DM);
        for (int i = gt; i < NV; i += NGT) z[i] = (v4u){0u, 0u, 0u, 0u};
        for (int i = gt; i < 8192 * 32; i += NGT) {
            const int pos = i >> 5, j = i & 31; double inv = 1.0; for (int q = 0; q < j; ++q) inv *= 0.7498942093324558273;
            const double ang = (double)pos * inv; const double k = rint(ang * 0.15915494309189533577); double r = ang - k * 6.283185307179586476925;
            const double qd = rint(r * 0.63661977236758134308); const double t = r - qd * 1.57079632679489661923; const double t2 = t * t;
            double sn = t * (1.0 + t2 * (-1.0 / 6 + t2 * (1.0 / 120 + t2 * (-1.0 / 5040 + t2 * (1.0 / 362880 + t2 * (-1.0 / 39916800 + t2 * (1.0 / 6227020800.0)))))));
            double cs = 1.0 + t2 * (-0.5 + t2 * (1.0 / 24 + t2 * (-1.0 / 720 + t2 * (1.0 / 40320 + t2 * (-1.0 / 3628800 + t2 * (1.0 / 479001600.0 + t2 * (-1.0 / 87178291200.0)))))));
            const int qi = ((int)qd) & 3; double c, s;
            if (qi == 0) { c = cs; s = sn; } else if (qi == 1) { c = -sn; s = cs; } else if (qi == 2) { c = -cs; s = -sn; } else { c = sn; s = -cs; }
            F.ROPE[2 * i] = (float)c; F.ROPE[2 * i + 1] = (float)s;
        }
    }
    for (int m = gw; m < M; m += NGW) {
        const float* xrow = m < M_P ? F.xp + (size_t)m * DM : F.xsm + (size_t)(m - M_P) * DM;
        const GAS f32x4* xr = (const GAS f32x4*)xrow + F.lane; f32x4 v[4]; float s = 0.f;
#pragma unroll
        for (int j = 0; j < 4; ++j) { v[j] = xr[64 * j]; s += (v[j].x * v[j].x + v[j].y * v[j].y) + (v[j].z * v[j].z + v[j].w * v[j].w); }
        const float rs = 1.f / sqrtf(wave_sum(s) * (1.f / DM) + EPS);
        GAS unsigned long long* o8 = (GAS unsigned long long*)(F.XN + (size_t)m * DM) + F.lane;
#pragma unroll
        for (int j = 0; j < 4; ++j) o8[64 * j] = (unsigned long long)pk2(v[j].x * rs, v[j].y * rs) | ((unsigned long long)pk2(v[j].z * rs, v[j].w * rs) << 32);
    }
}
__device__ __forceinline__ void nv_conv(Frame& F) {
    const int gt = F.bid * NT + F.tid, NGT = F.G * NT;
    for (int i = gt; i < M * 192; i += NGT) {
        const int row = i / 192, c8 = (i % 192) * 8; int seq0, pos, S; row_info(row, seq0, pos, S);
        float a[8];
#pragma unroll
        for (int e = 0; e < 8; ++e) a[e] = F.conv_b[c8 + e];
#pragma unroll
        for (int j = 0; j < 5; ++j) { const int p2 = pos + j - 2; if (p2 < 0 || p2 >= S) continue; const int r2 = seq0 + p2;
            const v4u w = c8 < 1024 ? *(const v4u*)(F.XS + (size_t)r2 * 1024 + c8) : *(const v4u*)(F.BCR + (size_t)r2 * 512 + (c8 - 1024));
            const float* cw = F.conv_w + j * 1536 + c8;
            a[0] += cw[0] * bflo(w.x); a[1] += cw[1] * bfhi(w.x); a[2] += cw[2] * bflo(w.y); a[3] += cw[3] * bfhi(w.y);
            a[4] += cw[4] * bflo(w.z); a[5] += cw[5] * bfhi(w.z); a[6] += cw[6] * bflo(w.w); a[7] += cw[7] * bfhi(w.w); }
#pragma unroll
        for (int e = 0; e < 8; ++e) a[e] = silu_f(a[e]);
        v4u o; o.x = pk2(a[0], a[1]); o.y = pk2(a[2], a[3]); o.z = pk2(a[4], a[5]); o.w = pk2(a[6], a[7]);
        *(v4u*)(F.XC + (size_t)row * 1536 + c8) = o;
    }
}
__device__ __forceinline__ void nv_ssd_chain(Frame& F, int item, int dir) {
    const int b = item >> 4, head = item & 15, g = head >> 3;
    const int S = b < 4 ? 4096 : 8192, seq0 = b < 4 ? b * 4096 : M_P + (b - 4) * 8192;
    LAS float* Bs = (LAS float*)(F.lds); LAS float* Cs = Bs + 32 * 128; LAS float* xs = Cs + 32 * 128; LAS float* dtv = xs + 32 * 64; LAS float* dAv = dtv + 32; LAS float* yp = dAv + 32;
    const int p = F.tid & 63, ng = F.wave;
    const float A = -__expf(dir ? F.alog_b[head] : F.alog_f[head]); const float dtb = dir ? F.dtb_b[head] : F.dtb_f[head]; const float Dh = F.dskip[head];
    float St[16];
#pragma unroll
    for (int j = 0; j < 16; ++j) St[j] = 0.f;
    for (int blk = 0; blk < S / 32; ++blk) {
        __syncthreads();
        for (int e = F.tid; e < 32 * 128; e += NT) { const int i = e >> 7, n = e & 127; const int t = dir ? S - 1 - (blk * 32 + i) : blk * 32 + i;
            const bf16* r = F.XC + (size_t)(seq0 + t) * 1536; Bs[e] = bf2f(r[1024 + g * 128 + n]); Cs[e] = bf2f(r[1280 + g * 128 + n]); }
        for (int e = F.tid; e < 32 * 64; e += NT) { const int i = e >> 6, pp = e & 63; const int t = dir ? S - 1 - (blk * 32 + i) : blk * 32 + i;
            xs[e] = bf2f(F.XC[(size_t)(seq0 + t) * 1536 + head * 64 + pp]); }
        if (F.tid < 32) { const int t = dir ? S - 1 - (blk * 32 + F.tid) : blk * 32 + F.tid; const float raw = F.DT[(size_t)(seq0 + t) * 32 + dir * 16 + head] + dtb;
            const float dt = raw > 20.f ? raw : log1pf(__expf(raw)); dtv[F.tid] = dt; dAv[F.tid] = __expf(dt * A); }
        __syncthreads();
        for (int i = 0; i < 32; ++i) {
            const float xdt = xs[i * 64 + p] * dtv[i], da = dAv[i]; float y = 0.f;
#pragma unroll
            for (int j = 0; j < 16; ++j) { const int n = ng * 16 + j; St[j] = St[j] * da + xdt * Bs[i * 128 + n]; y += Cs[i * 128 + n] * St[j]; }
            yp[(i * 8 + ng) * 64 + p] = y;
        }
        __syncthreads();
        for (int e = F.tid; e < 2048; e += NT) { const int i = e >> 6, pp = e & 63; float y = 0.f;
#pragma unroll
            for (int q = 0; q < 8; ++q) y += yp[(i * 8 + q) * 64 + pp];
            const int t = dir ? S - 1 - (blk * 32 + i) : blk * 32 + i; const size_t row = (size_t)(seq0 + t);
            if (dir == 0) F.YF[row * 1024 + head * 64 + pp] = (bf16)f2bf(y);
            else { const float tot = y + bf2f(F.YF[row * 1024 + head * 64 + pp]) + Dh * xs[i * 64 + pp];
                bf16* zp = F.MIX + row * 2048 + head * 64 + pp; const float val = tot * silu_f(bf2f(*zp)); *zp = (bf16)f2bf(val);
                const float sq = wave_sum(val * val); if (F.lane == 0) atomicAdd(F.SSQ_SSD + row, sq); }
        }
    }
}
__device__ __forceinline__ void nv_attn_unit(Frame& F, int unit) {
    const int idx = unit * NT + F.tid; const int head = idx / M, row = idx % M; int seq0, pos, S; row_info(row, seq0, pos, S);
    float q[64], o[64];
    { const v4u* qp = (const v4u*)(F.MIX + (size_t)row * 2048 + 1024 + head * 64);
#pragma unroll
      for (int c = 0; c < 8; ++c) { const v4u w = qp[c]; q[8 * c] = bflo(w.x); q[8 * c + 1] = bfhi(w.x); q[8 * c + 2] = bflo(w.y); q[8 * c + 3] = bfhi(w.y); q[8 * c + 4] = bflo(w.z); q[8 * c + 5] = bfhi(w.z); q[8 * c + 6] = bflo(w.w); q[8 * c + 7] = bfhi(w.w); } }
#pragma unroll
    for (int d = 0; d < 64; ++d) o[d] = 0.f;
    float mx = -INFINITY, l = 0.f;
    for (int pat = 0; pat < 3; ++pat) { const int dil = pat == 0 ? 1 : (pat == 1 ? 4 : 16);
        for (int mm = -64; mm <= 64; ++mm) { const int p2 = pos + mm * dil; if (p2 < 0 || p2 >= S) continue; const size_t r2 = (size_t)(seq0 + p2);
            const v4u* kp = (const v4u*)(F.KB + r2 * 1024 + head * 64); float s = 0.f;
#pragma unroll
            for (int c = 0; c < 8; ++c) { const v4u w = kp[c]; s += q[8 * c] * bflo(w.x) + q[8 * c + 1] * bfhi(w.x) + q[8 * c + 2] * bflo(w.y) + q[8 * c + 3] * bfhi(w.y) + q[8 * c + 4] * bflo(w.z) + q[8 * c + 5] * bfhi(w.z) + q[8 * c + 6] * bflo(w.w) + q[8 * c + 7] * bfhi(w.w); }
            if (s > mx) { const float f = exp2f(mx - s); l *= f;
#pragma unroll
                for (int d = 0; d < 64; ++d) o[d] *= f;
                mx = s; }
            const float pw = exp2f(s - mx); l += pw;
            const v4u* vp = (const v4u*)(F.VB + r2 * 1024 + head * 64);
#pragma unroll
            for (int c = 0; c < 8; ++c) { const v4u w = vp[c]; o[8 * c] += pw * bflo(w.x); o[8 * c + 1] += pw * bfhi(w.x); o[8 * c + 2] += pw * bflo(w.y); o[8 * c + 3] += pw * bfhi(w.y); o[8 * c + 4] += pw * bflo(w.z); o[8 * c + 5] += pw * bfhi(w.z); o[8 * c + 6] += pw * bflo(w.w); o[8 * c + 7] += pw * bfhi(w.w); }
        } }
    const float il = 1.f / l; const v4u* zp = (const v4u*)(F.ZA + (size_t)row * 1024 + head * 64); v4u* op = (v4u*)(F.MIX + (size_t)row * 2048 + 1024 + head * 64);
#pragma unroll
    for (int c = 0; c < 8; ++c) { const v4u z = zp[c]; v4u w;
        w.x = pk2(o[8 * c] * il * silu_f(bflo(z.x)), o[8 * c + 1] * il * silu_f(bfhi(z.x))); w.y = pk2(o[8 * c + 2] * il * silu_f(bflo(z.y)), o[8 * c + 3] * il * silu_f(bfhi(z.y)));
        w.z = pk2(o[8 * c + 4] * il * silu_f(bflo(z.z)), o[8 * c + 5] * il * silu_f(bfhi(z.z))); w.w = pk2(o[8 * c + 6] * il * silu_f(bflo(z.w)), o[8 * c + 7] * il * silu_f(bfhi(z.w)));
        op[c] = w; }
}
__device__ __forceinline__ void nv_ssd_norm(Frame& F) {
    const int gt = F.bid * NT + F.tid, NGT = F.G * NT;
    for (int i = gt; i < M * 128; i += NGT) { const int row = i >> 7, c8 = (i & 127) * 8; const float rs = 1.f / sqrtf(F.SSQ_SSD[row] * (1.f / 1024.f) + EPS);
        v4u* p = (v4u*)(F.MIX + (size_t)row * 2048 + c8); v4u w = *p;
        w.x = pk2(bflo(w.x) * rs, bfhi(w.x) * rs); w.y = pk2(bflo(w.y) * rs, bfhi(w.y) * rs); w.z = pk2(bflo(w.z) * rs, bfhi(w.z) * rs); w.w = pk2(bflo(w.w) * rs, bfhi(w.w) * rs); *p = w; }
}
__device__ __forceinline__ void final_norm(Frame& F) {
    const int gt = F.bid * NT + F.tid, NGT = F.G * NT;
    for (int i = gt; i < M * 256; i += NGT) { const int row = i >> 8, c4 = (i & 255) * 4; const float rs = 1.f / sqrtf(F.SSQ_OUT[row] * (1.f / 1024.f) + EPS);
        f32x4* p = (f32x4*)(F.out + (size_t)row * 1024 + c4); const f32x4 g = *(const f32x4*)(F.norm_f + c4); *p = *p * rs * g; }
}
#ifndef MK_ONE_LAUNCH
#define MK_ONE_LAUNCH 0
#endif
constexpr int NPHASE = 8;
__global__ void __launch_bounds__(NT, 2) hybrid_fwd(Args args) {
    extern __shared__ __attribute__((aligned(16))) unsigned char lds[];
    Frame F;
    F.lds = (LAS unsigned char*)lds; F.tid = threadIdx.x; F.lane = F.tid & 63; F.wave = __builtin_amdgcn_readfirstlane(F.tid >> 6); F.G = gridDim.x; F.bid = blockIdx.x;
    F.xp = args.in[0]; F.xsm = args.in[1]; F.w_in = args.in[2]; F.conv_w = args.in[3]; F.conv_b = args.in[4]; F.dtb_f = args.in[5]; F.dtb_b = args.in[6];
    F.alog_f = args.in[7]; F.alog_b = args.in[8]; F.dskip = args.in[9]; F.norm_ssd = args.in[10]; F.norm_in = args.in[11]; F.w_out = args.in[12]; F.norm_f = args.in[13];
    F.out = args.out; F.ws = args.ws; unsigned char* ws = args.ws;
    F.WIN = (bf16*)(ws + WS_WIN); F.WOUT = (bf16*)(ws + WS_WOUT); F.ROPE = (float*)(ws + WS_ROPE); F.DT = (float*)(ws + WS_DT); F.MIX = (bf16*)(ws + WS_MIX);
    F.KB = (bf16*)(ws + WS_K); F.VB = (bf16*)(ws + WS_V); F.ZA = (bf16*)(ws + WS_ZA); F.XS = (bf16*)(ws + WS_XS); F.BCR = (bf16*)(ws + WS_BCR);
    F.XN = (bf16*)args.out;
    F.XC = (bf16*)args.out; F.YF = (bf16*)(ws + WS_FREE);
    F.SSQ_SSD = (float*)(ws + WS_CTL + CTL_SSQ_SSD); F.SSQ_OUT = (float*)(ws + WS_CTL + CTL_SSQ_OUT);
    for (int u = F.tid; u < (LDS_BYTES - LDSCTL_OFF) / 4; u += NT) ((LAS unsigned*)(F.lds + LDSCTL_OFF))[u] = 0u;
    __syncthreads();
    XcdBarrier bar; bar.bar = (unsigned*)(ws + WS_CTL) + CW_BAR; bar.x = 0; bar.st = nullptr;
    if (MK_ONE_LAUNCH) bar = xcd_barrier_post((unsigned*)(ws + WS_CTL) + CW_BAR, (volatile LAS unsigned*)(F.lds + MISC_OFF) + 8);
    const int lo = args.ph_lo, hi = args.ph_hi;
#define IN(k) (lo <= (k) && (k) < hi)
#define SEAM(k) do { if (IN(k) && IN((k) + 1)) xcd_barrier(bar); } while (0)
    if (IN(0)) { p0_prologue(F); SEAM(0); }
    if (IN(1)) {
        pg8::Gemm g{F.XN, F.WIN, M, NPAD, DM}; pg8::StaticOrder S; S.init(M, NPAD, F.G, F.bid);
        pg8::EpiInProj E{F.MIX, F.KB, F.VB, F.ZA, F.XS, F.BCR, F.DT, F.ROPE};
        pg8::gemm_phase<pg8::EpiInProj, pg8::StaticOrder, true, true>(F.lds + RING_OFF, g, S, E);
        SEAM(1);
    }
    if (IN(2)) { nv_conv(F); SEAM(2); }
    if (IN(3)) {
        if (F.bid < 128) nv_ssd_chain(F, F.bid, 0);
        __syncthreads();
        for (int u = F.bid; u < M * 16 / NT; u += F.G) nv_attn_unit(F, u);
        SEAM(3);
    }
    if (IN(4)) { if (F.bid < 128) nv_ssd_chain(F, F.bid, 1); SEAM(4); }
    if (IN(5)) { nv_ssd_norm(F); SEAM(5); }
    if (IN(6)) {
        pg8::Gemm g{F.MIX, F.WOUT, M, DM, KOUT}; pg8::StaticOrder S; S.init(M, DM, F.G, F.bid);
        pg8::EpiOutProj E{F.xp, F.xsm, F.out, F.SSQ_OUT};
        pg8::gemm_phase<pg8::EpiOutProj, pg8::StaticOrder, true, true>(F.lds + RING_OFF, g, S, E);
        SEAM(6);
    }
    if (IN(7)) final_norm(F);
#undef IN
#undef SEAM
}
extern "C" void kernel_launch(void* const* d_in, const int* in_sizes, int n_in, void* d_out, int out_size, void* d_ws, size_t ws_size, hipStream_t stream) {
    static int grid = 0;
    if (grid == 0) {
        if (n_in != 14 || out_size != M * DM || ws_size < WS_END) { fprintf(stderr, "kernel_launch: unexpected problem: n_in %d out %d ws %zu\n", n_in, out_size, ws_size); grid = -1; return; }
        int dev = 0, cus = 0, per_cu = 0;
        if (hipGetDevice(&dev) != hipSuccess || hipDeviceGetAttribute(&cus, hipDeviceAttributeMultiprocessorCount, dev) != hipSuccess) { grid = -1; return; }
        if (hipFuncSetAttribute((const void*)hybrid_fwd, hipFuncAttributeMaxDynamicSharedMemorySize, LDS_BYTES) != hipSuccess) { fprintf(stderr, "kernel_launch: hipFuncSetAttribute failed\n"); grid = -1; return; }
        if (hipOccupancyMaxActiveBlocksPerMultiprocessor(&per_cu, (const void*)hybrid_fwd, NT, LDS_BYTES) != hipSuccess || per_cu < 1) { fprintf(stderr, "kernel_launch: occupancy query says %d\n", per_cu); per_cu = 1; }
        (void)hipGetLastError();
        grid = cus;
    }
    if (grid < 0) return;
    (void)hipMemsetAsync((char*)d_ws + WS_CTL, 0, CTL_ZERO_BYTES, stream);
    Args a{};
    for (int i = 0; i < 14; ++i) a.in[i] = (const float*)d_in[i];
    a.out = (float*)d_out; a.ws = (unsigned char*)d_ws;
#if MK_ONE_LAUNCH
    a.ph_lo = 0; a.ph_hi = NPHASE;
    hipLaunchKernelGGL(hybrid_fwd, dim3(grid), dim3(NT), LDS_BYTES, stream, a);
#else
    for (int p = 0; p < NPHASE; ++p) { a.ph_lo = p; a.ph_hi = p + 1; hipLaunchKernelGGL(hybrid_fwd, dim3(grid), dim3(NT), LDS_BYTES, stream, a); }
#endif
}
```

```cpp
#include <hip/hip_runtime.h>
#include <cstdio>
#include <cstdint>
#include <cmath>
namespace pg8 {
#define PG8_LAS __attribute__((address_space(3)))
typedef unsigned short bf16_t;
typedef short bf16x8 __attribute__((ext_vector_type(8)));
typedef float f32x4 __attribute__((ext_vector_type(4)));
typedef unsigned u32x4 __attribute__((ext_vector_type(4)));
constexpr int BM = 256, BK = 64, HALF = 128, HTB = HALF * BK * 2  , STAGE_BYTES = 8 * HTB, NXCD = 8, WGM = 8;

__host__ __device__ __forceinline__ int lds_byte(int r, int c) { const int st = (r >> 4) * 2 + (c >> 5), rr = r & 15, cc = c & 31, ob = rr * 64 + cc * 2; return st * 1024 + (ob ^ (((ob >> 9) & 1) << 5)); }
__host__ __device__ __forceinline__ void stage_rc(int b, int& R, int& C) { const int st = b / 1024, sb = b % 1024, swz = sb ^ (((sb >> 9) & 1) << 5); R = (st >> 1) * 16 + swz / 64; C = (st & 1) * 32 + (swz % 64) / 2; }
__host__ __device__ __forceinline__ int perm32(int rho) { const int n = rho >> 4, i = rho & 15; return 8 * (i >> 2) + 4 * n + (i & 3); }

struct Unit { int pm, pn; };
struct Gemm { const bf16_t* A; const bf16_t* Bt; int M, N, K; };

struct StaticOrder {
    int nM, nN, nwg, G, c;
    __host__ __device__ void init(int M, int N, int G_, int c_) { nM = M / BM; nN = N / BM; nwg = nM * nN; G = G_; c = c_; }
    __host__ __device__ bool next(int i, Unit& u) const {
        const long L = (long)i * G + c; if (L >= nwg) return false;
        int wgid = (int)L; { const int q = nwg / NXCD, r = nwg % NXCD, xcd = wgid % NXCD, off = wgid / NXCD; wgid = (xcd < r ? xcd * (q + 1) : r * (q + 1) + (xcd - r) * q) + off; }
        const int nig = WGM * nN, gid = wgid / nig, fm = gid * WGM, gsz = (nM - fm) < WGM ? (nM - fm) : WGM;
        u.pm = fm + ((wgid % nig) % gsz); u.pn = (wgid % nig) / gsz; return true;
    }
    __device__ __forceinline__ void a_ready(const Unit&) const {}
    __device__ __forceinline__ void done(const Unit&) const {}
};

__device__ __forceinline__ unsigned cvt_pk_bf16(float lo, float hi) { unsigned r; asm volatile("v_cvt_pk_bf16_f32 %0, %1, %2" : "=v"(r) : "v"(lo), "v"(hi)); return r; }
typedef float f32x2 __attribute__((ext_vector_type(2)));
__device__ __forceinline__ f32x2 gelu_pk(f32x2 v) {
    const f32x2 av = __builtin_elementwise_abs(v), d = av * 0.2316418882f + 1.0f;
    f32x2 t; t.x = __builtin_amdgcn_rcpf(d.x); t.y = __builtin_amdgcn_rcpf(d.y);
    f32x2 q = t * 0.5307027145f + (-0.7265760135f); q = q * t + 0.7107068705f; q = q * t + (-0.142248368f); q = q * t + 0.127414796f; q = q * t;
    const f32x2 s = (v * v) * (-0.72134752044f);
    f32x2 e; e.x = __builtin_amdgcn_exp2f(s.x); e.y = __builtin_amdgcn_exp2f(s.y);
    const f32x2 m = v * (q * e), r = v - m;
    f32x2 o; o.x = v.x < 0.f ? m.x : r.x; o.y = v.y < 0.f ? m.y : r.y; return o;
}

struct EpiInProj {
    static constexpr bool PERM = true, AFTER_DRAIN = false;
    bf16_t *MIX, *KB, *VB, *ZA, *XS, *BCR; float* DT; const float* rope;
    __device__ __forceinline__ void operator()(const f32x4 (&acc)[2][2][4][2], const Unit& u, int wr, int wc, int fr, int fq) const {
        const int row0 = u.pm * BM + wr * 64 + fr; const int pn = u.pn;
        if (pn == 26) {
            if (wc == 0) {
#pragma unroll
                for (int ai = 0; ai < 2; ++ai)
#pragma unroll
                    for (int m = 0; m < 4; ++m) { float* rp = DT + (size_t)(row0 + ai * HALF + m * 16) * 32 + 8 * fq;
                        *(f32x4*)rp = acc[ai][0][m][0]; *(f32x4*)(rp + 4) = acc[ai][0][m][1]; }
            }
            return;
        }
        bf16_t* base; int ldc, colt, mode = 0;
        if (pn < 4)       { base = MIX + 1024; ldc = 2048; colt = pn * 256; mode = 1; }
        else if (pn < 8)  { base = KB;  ldc = 1024; colt = (pn - 4) * 256; mode = 2; }
        else if (pn < 12) { base = VB;  ldc = 1024; colt = (pn - 8) * 256; }
        else if (pn < 16) { base = ZA;  ldc = 1024; colt = (pn - 12) * 256; }
        else if (pn < 20) { base = MIX; ldc = 2048; colt = (pn - 16) * 256; }
        else if (pn < 24) { base = XS;  ldc = 1024; colt = (pn - 20) * 256; }
        else              { base = BCR; ldc = 512;  colt = (pn - 24) * 256; }
        const int col0 = colt + wc * 32 + 8 * fq;
        const float qs = (mode == 1) ? 0.125f * 1.4426950408889634f : 1.0f;
        const int j0 = (wc & 1) * 16 + 4 * fq;
#pragma unroll
        for (int ai = 0; ai < 2; ++ai)
#pragma unroll
            for (int m = 0; m < 4; ++m) {
                const int row = row0 + ai * HALF + m * 16;
                bf16_t* rowp = base + (size_t)row * ldc + col0;
                f32x4 cs0 = {1.f, 0.f, 1.f, 0.f}, cs1 = {1.f, 0.f, 1.f, 0.f};
                if (mode != 0) { const int pos = row < 16384 ? (row & 4095) : ((row - 16384) & 8191);
                    const float* rp = rope + ((size_t)pos * 32 + j0) * 2; cs0 = *(const f32x4*)rp; cs1 = *(const f32x4*)(rp + 4); }
#pragma unroll
                for (int bj = 0; bj < 2; ++bj) {
                    f32x4 v0 = acc[ai][bj][m][0], v1 = acc[ai][bj][m][1];
                    if (mode != 0) {
                        f32x4 a, b;
                        a[0] = v0[0] * cs0[0] - v0[1] * cs0[1]; a[1] = v0[1] * cs0[0] + v0[0] * cs0[1];
                        a[2] = v0[2] * cs0[2] - v0[3] * cs0[3]; a[3] = v0[3] * cs0[2] + v0[2] * cs0[3];
                        b[0] = v1[0] * cs1[0] - v1[1] * cs1[1]; b[1] = v1[1] * cs1[0] + v1[0] * cs1[1];
                        b[2] = v1[2] * cs1[2] - v1[3] * cs1[3]; b[3] = v1[3] * cs1[2] + v1[2] * cs1[3];
                        v0 = a * qs; v1 = b * qs;
                    }
                    u32x4 w; w.x = cvt_pk_bf16(v0[0], v0[1]); w.y = cvt_pk_bf16(v0[2], v0[3]); w.z = cvt_pk_bf16(v1[0], v1[1]); w.w = cvt_pk_bf16(v1[2], v1[3]);
                    *(u32x4*)(rowp + bj * HALF) = w;
                }
            }
    }
};
struct EpiOutProj {
    static constexpr bool PERM = false, AFTER_DRAIN = false;
    const float* xp; const float* xs; float* out; float* ssq;
    __device__ __forceinline__ void operator()(const f32x4 (&acc)[2][2][4][2], const Unit& u, int wr, int wc, int fr, int fq) const {
        const int row0 = u.pm * BM + wr * 64 + fr; const int col0 = u.pn * BM + wc * 32 + 4 * fq;
#pragma unroll
        for (int ai = 0; ai < 2; ++ai)
#pragma unroll
            for (int m = 0; m < 4; ++m) {
                const int row = row0 + ai * HALF + m * 16;
                const float* xr = (row < 16384 ? xp + (size_t)row * 1024 : xs + (size_t)(row - 16384) * 1024) + col0;
                float* orow = out + (size_t)row * 1024 + col0; float s = 0.f;
#pragma unroll
                for (int bj = 0; bj < 2; ++bj)
#pragma unroll
                    for (int n = 0; n < 2; ++n) { const f32x4 o = *(const f32x4*)(xr + bj * HALF + n * 16) + acc[ai][bj][m][n];
                        *(f32x4*)(orow + bj * HALF + n * 16) = o; s += (o[0] * o[0] + o[1] * o[1]) + (o[2] * o[2] + o[3] * o[3]); }
                s += __shfl_xor(s, 16); s += __shfl_xor(s, 32);
                if (fq == 0) atomicAdd(ssq + row, s);
            }
    }
};
template <class Epi, class Sched, bool ALIGN_EPI = false, bool SP2 = false>
__device__ __forceinline__ void gemm_phase(PG8_LAS unsigned char* lds, const Gemm g, const Sched& S, const Epi& E) {
    const int tid = threadIdx.x, wid = __builtin_amdgcn_readfirstlane(tid >> 6), lane = tid & 63, wr = wid >> 2, wc = wid & 3, fr = lane & 15, fq = lane >> 4;
    const int K = g.K, nt = K / BK;
    unsigned voffA[2], voffB[2];
#pragma unroll
    for (int i = 0; i < 2; ++i) { int R, C; stage_rc(tid * 16 + i * 8192, R, C); const int Rb = Epi::PERM ? ((R & ~31) + perm32(R & 31)) : R;
        voffA[i] = (unsigned)(R * K + C) * 2u; voffB[i] = (unsigned)(Rb * K + C) * 2u; }
    const size_t kstep = (size_t)(BK * 2);
    const size_t hstep = (size_t)HALF * K * 2;
    const size_t tstep = 2 * hstep;
    const unsigned ldsw = (unsigned)wid * 1024u;
    const int aoff = lds_byte(wr * 64 + fr, fq * 8), boff = lds_byte(wc * 32 + fr, fq * 8);
#define PG8_SA(b, h) (((b) * 2 + (h)) * HTB)
#define PG8_SB(b, h) ((4 + (b) * 2 + (h)) * HTB)
#define PG8_STAGE(bufoff, gbase, voff) do { _Pragma("unroll") for (int _i = 0; _i < 2; ++_i) \
        __builtin_amdgcn_global_load_lds((const unsigned*)((const char*)(gbase) + (voff)[_i]), (PG8_LAS unsigned*)(lds + (bufoff) + ldsw + _i * 8192), 16, 0, 0); } while (0)
#define PG8_LDA(dst, b, h) do { _Pragma("unroll") for (int m = 0; m < 4; ++m) _Pragma("unroll") for (int k = 0; k < 2; ++k) dst[m][k] = *(const PG8_LAS bf16x8*)(lds + PG8_SA(b, h) + aoff + m * 2048 + k * 1024); } while (0)
#define PG8_LDB(dst, b, h) do { _Pragma("unroll") for (int n = 0; n < 2; ++n) _Pragma("unroll") for (int k = 0; k < 2; ++k) dst[n][k] = *(const PG8_LAS bf16x8*)(lds + PG8_SB(b, h) + boff + n * 2048 + k * 1024); } while (0)
#define PG8_MMA(ai, bj, At, Bt) do { __builtin_amdgcn_s_setprio(1); _Pragma("unroll") for (int m = 0; m < 4; ++m) _Pragma("unroll") for (int n = 0; n < 2; ++n) _Pragma("unroll") for (int k = 0; k < 2; ++k) \
        acc[ai][bj][m][n] = __builtin_amdgcn_mfma_f32_16x16x32_bf16(Bt[n][k], At[m][k], acc[ai][bj][m][n], 0, 0, 0); __builtin_amdgcn_s_setprio(0); } while (0)
#define PG8_WAIT_V(n) asm volatile("s_waitcnt vmcnt(" #n ")" ::: "memory")
#define PG8_WAIT_L(n) asm volatile("s_waitcnt lgkmcnt(" #n ")" ::: "memory")
#define PG8_BAR __builtin_amdgcn_s_barrier()
#define PG8_SCHED __builtin_amdgcn_sched_barrier(0)
    Unit cur, nxt; int ui = 0;
    if (!S.next(0, cur)) return;
    f32x4 acc[2][2][4][2];
#pragma unroll
    for (int a = 0; a < 2; ++a)
#pragma unroll
        for (int b = 0; b < 2; ++b)
#pragma unroll
            for (int m = 0; m < 4; ++m)
#pragma unroll
                for (int n = 0; n < 2; ++n) acc[a][b][m][n] = (f32x4){0.f, 0.f, 0.f, 0.f};
    bf16x8 At[4][2], B0[2][2], B1[2][2];
    const char* cA = (const char*)g.A + (size_t)cur.pm * tstep; const char* cB = (const char*)g.Bt + (size_t)cur.pn * tstep;
    S.a_ready(cur);
    if constexpr (SP2) {
        PG8_STAGE(PG8_SB(0, 0), cB, voffB); PG8_STAGE(PG8_SB(0, 1), cB + hstep, voffB); PG8_STAGE(PG8_SA(0, 0), cA, voffA); PG8_STAGE(PG8_SA(0, 1), cA + hstep, voffA);
        if (wr == 1) PG8_BAR;
        PG8_WAIT_V(2); PG8_BAR;
        PG8_STAGE(PG8_SB(1, 0), cB + kstep, voffB); PG8_STAGE(PG8_SA(1, 0), cA + kstep, voffA); PG8_STAGE(PG8_SB(1, 1), cB + hstep + kstep, voffB);
        PG8_WAIT_V(6); PG8_BAR;
    } else {
        PG8_STAGE(PG8_SB(0, 0), cB, voffB); PG8_STAGE(PG8_SA(0, 0), cA, voffA); PG8_STAGE(PG8_SB(0, 1), cB + hstep, voffB); PG8_STAGE(PG8_SA(0, 1), cA + hstep, voffA);
        if (wr == 1) PG8_BAR;
        PG8_WAIT_V(4); PG8_BAR;
        PG8_STAGE(PG8_SB(1, 0), cB + kstep, voffB); PG8_STAGE(PG8_SA(1, 0), cA + kstep, voffA); PG8_STAGE(PG8_SB(1, 1), cB + hstep + kstep, voffB);
        PG8_WAIT_V(6); PG8_BAR;
    }
    for (;;) {
        const bool has_next = S.next(ui + 1, nxt);
        const char* nA = has_next ? (const char*)g.A + (size_t)nxt.pm * tstep : cA; const char* nB = has_next ? (const char*)g.Bt + (size_t)nxt.pn * tstep : cB;
        for (int t = 0; t < nt; t += 2) {
            const bool last = (t == nt - 2);
            const char* a1 = cA + (size_t)(t + 1) * kstep;
            const char* a2 = last ? nA : cA + (size_t)(t + 2) * kstep; const char* b2 = last ? nB : cB + (size_t)(t + 2) * kstep;
            const char* a3 = a2 + kstep; const char* b3 = b2 + kstep;
            if (last && has_next) S.a_ready(nxt);
            if constexpr (SP2) {
            PG8_LDB(B0, 0, 0); PG8_LDB(B1, 0, 1); PG8_SCHED; PG8_LDA(At, 0, 0); PG8_STAGE(PG8_SA(1, 1), a1 + hstep, voffA);
            PG8_WAIT_V(8); PG8_WAIT_L(0); PG8_BAR; PG8_MMA(0, 0, At, B0); PG8_MMA(0, 1, At, B1); PG8_BAR; PG8_SCHED;
            PG8_LDA(At, 0, 1); PG8_STAGE(PG8_SB(0, 0), b2, voffB); PG8_STAGE(PG8_SB(0, 1), b2 + hstep, voffB); PG8_STAGE(PG8_SA(0, 0), a2, voffA);
            PG8_WAIT_V(8); PG8_WAIT_L(0); PG8_BAR; PG8_MMA(1, 0, At, B0); PG8_MMA(1, 1, At, B1); PG8_BAR; PG8_SCHED;
            PG8_LDB(B0, 1, 0); PG8_LDB(B1, 1, 1); PG8_SCHED; PG8_LDA(At, 1, 0); PG8_STAGE(PG8_SA(0, 1), a2 + hstep, voffA);
            PG8_WAIT_V(8); PG8_WAIT_L(0); PG8_BAR; PG8_MMA(0, 0, At, B0); PG8_MMA(0, 1, At, B1); PG8_BAR; PG8_SCHED;
            PG8_LDA(At, 1, 1); PG8_STAGE(PG8_SB(1, 0), b3, voffB); PG8_STAGE(PG8_SB(1, 1), b3 + hstep, voffB); PG8_STAGE(PG8_SA(1, 0), a3, voffA);
            PG8_WAIT_V(8); PG8_WAIT_L(0); PG8_BAR; PG8_MMA(1, 0, At, B0); PG8_MMA(1, 1, At, B1); PG8_BAR; PG8_SCHED;
            } else {
            PG8_LDB(B0, 0, 0); PG8_SCHED; PG8_LDA(At, 0, 0); PG8_STAGE(PG8_SA(1, 1), a1 + hstep, voffA);
            PG8_WAIT_L(8); PG8_BAR; PG8_WAIT_L(0); PG8_MMA(0, 0, At, B0); PG8_BAR; PG8_SCHED;
            PG8_LDB(B1, 0, 1); PG8_STAGE(PG8_SB(0, 0), b2, voffB);
            PG8_BAR; PG8_WAIT_L(0); PG8_MMA(0, 1, At, B1); PG8_BAR;
            PG8_LDA(At, 0, 1); PG8_STAGE(PG8_SA(0, 0), a2, voffA);
            PG8_BAR; PG8_WAIT_L(0); PG8_MMA(1, 0, At, B0); PG8_BAR; PG8_SCHED;
            PG8_STAGE(PG8_SB(0, 1), b2 + hstep, voffB);
            PG8_WAIT_V(6); PG8_BAR; PG8_MMA(1, 1, At, B1); PG8_BAR;
            PG8_LDB(B0, 1, 0); PG8_SCHED; PG8_LDA(At, 1, 0); PG8_STAGE(PG8_SA(0, 1), a2 + hstep, voffA);
            PG8_WAIT_L(8); PG8_BAR; PG8_WAIT_L(0); PG8_MMA(0, 0, At, B0); PG8_BAR; PG8_SCHED;
            PG8_LDB(B1, 1, 1); PG8_STAGE(PG8_SB(1, 0), b3, voffB);
            PG8_BAR; PG8_WAIT_L(0); PG8_MMA(0, 1, At, B1); PG8_BAR;
            PG8_LDA(At, 1, 1); PG8_STAGE(PG8_SA(1, 0), a3, voffA);
            PG8_BAR; PG8_WAIT_L(0); PG8_MMA(1, 0, At, B0); PG8_BAR; PG8_SCHED;
            PG8_STAGE(PG8_SB(1, 1), b3 + hstep, voffB);
            PG8_WAIT_V(6); PG8_BAR; PG8_MMA(1, 1, At, B1); PG8_BAR;
            }
        }
        if constexpr (ALIGN_EPI) { if (wr == 0) PG8_BAR; }
        if constexpr (!Epi::AFTER_DRAIN) { E(acc, cur, wr, wc, fr, fq); S.done(cur); }
        if (!has_next) break;
#pragma unroll
        for (int a = 0; a < 2; ++a)
#pragma unroll
            for (int b = 0; b < 2; ++b)
#pragma unroll
                for (int m = 0; m < 4; ++m)
#pragma unroll
                    for (int n = 0; n < 2; ++n) acc[a][b][m][n] = (f32x4){0.f, 0.f, 0.f, 0.f};
        cur = nxt; cA = nA; cB = nB; ++ui;
        if constexpr (ALIGN_EPI) { if (wr == 1) PG8_BAR; }
    }
    PG8_WAIT_V(0);
    if constexpr (!ALIGN_EPI) { if (wr == 0) PG8_BAR; }
    PG8_BAR;
    if constexpr (Epi::AFTER_DRAIN) { E.fused(acc, cur, wr, wc, fr, fq, lds, wid, lane); S.done(cur); }
#undef PG8_SA
#undef PG8_SB
#undef PG8_STAGE
#undef PG8_LDA
#undef PG8_LDB
#undef PG8_MMA
#undef PG8_WAIT_V
#undef PG8_WAIT_L
#undef PG8_BAR
#undef PG8_SCHED
}
}
constexpr int NWAVES = 8, NT = NWAVES * 64;
constexpr int DM = 1024, M_P = 4 * 4096, M_S = 4 * 8192, M = M_P + M_S;
constexpr int NPROJ = 6688, NPAD = 6912, KOUT = 2048;
constexpr float EPS = 1e-5f;
constexpr size_t MiB = 1u << 20;
constexpr size_t WS_CTL = 0, CTL_ZERO_BYTES = 1 * MiB;
constexpr size_t CTL_SSQ_SSD = 256 * 1024, CTL_SSQ_OUT = 512 * 1024;
constexpr size_t WS_WIN = 2 * MiB;
constexpr size_t WS_WOUT = 16 * MiB;
constexpr size_t WS_ROPE = 20 * MiB;
constexpr size_t WS_DT = 22 * MiB;
constexpr size_t WS_MIX = 32 * MiB;
constexpr size_t WS_K = 224 * MiB, WS_V = 320 * MiB, WS_ZA = 416 * MiB, WS_XS = 512 * MiB;
constexpr size_t WS_BCR = 608 * MiB;
constexpr size_t WS_FREE = 656 * MiB;
constexpr size_t WS_END = 768 * MiB;
constexpr int CW_BAR = 4096;
constexpr int RING_OFF = 0, RING_BYTES = 131072;
constexpr int LDSCTL_OFF = RING_BYTES, MISC_OFF = LDSCTL_OFF + 320;
constexpr int LDS_BYTES = 147456;
#define GAS __attribute__((address_space(1)))
#define LAS __attribute__((address_space(3)))
typedef unsigned short bf16;
typedef unsigned v4u __attribute__((ext_vector_type(4)));
typedef unsigned v2u __attribute__((ext_vector_type(2)));
typedef float f32x4 __attribute__((ext_vector_type(4)));
#define LDS_WAIT() asm volatile("s_waitcnt lgkmcnt(0)" ::: "memory")
#define VM_WAIT() asm volatile("s_waitcnt vmcnt(0)" ::: "memory")
__device__ __forceinline__ unsigned f2bf(float f) { unsigned u = __builtin_bit_cast(unsigned, f); return (u + 0x7fffu + ((u >> 16) & 1u)) >> 16; }
__device__ __forceinline__ unsigned pk2(float lo, float hi) { return f2bf(lo) | (f2bf(hi) << 16); }
__device__ __forceinline__ float bf2f(unsigned short b) { return __builtin_bit_cast(float, (unsigned)b << 16); }
__device__ __forceinline__ float bflo(unsigned w) { return __builtin_bit_cast(float, w << 16); }
__device__ __forceinline__ float bfhi(unsigned w) { return __builtin_bit_cast(float, w & 0xffff0000u); }
__device__ __forceinline__ float silu_f(float v) { return v / (1.f + __expf(-v)); }
#define XB_TMO      128
#define XB_XCNT(j)  (256  + 64 * (j))
#define XB_XSUB(j)  (1280 + 64 * (j))
#define XB_XGEN(j)  (2304 + 64 * (j))
#define XB_TOP      3328
#define XB_TOPGEN   3392
#define XCD_BAR_WORDS 3456
#define XB_SPIN_CAP (1u << 18)

__device__ __forceinline__ unsigned xb_ld(unsigned* p)              { return __hip_atomic_load(p, __ATOMIC_RELAXED, __HIP_MEMORY_SCOPE_AGENT); }
__device__ __forceinline__ unsigned xb_add(unsigned* p, unsigned v) { return __hip_atomic_fetch_add(p, v, __ATOMIC_RELAXED, __HIP_MEMORY_SCOPE_AGENT); }
__device__ __forceinline__ unsigned xb_xcc_id() { return (unsigned)__builtin_amdgcn_s_getreg((3 << 11) | 20) & 0xFu; }
#define XB_SPIN(cond, bar) do { unsigned _sp = 0; while (cond) { __builtin_amdgcn_s_sleep(1); \
    if ((++_sp & 255u) == 0u) { if (xb_ld(&(bar)[XB_TMO])) break; if (_sp > XB_SPIN_CAP) { atomicAdd(&(bar)[XB_TMO], 1u); break; } } } } while (0)

struct XcdBarrier {
    unsigned* bar; unsigned x;
    volatile LAS unsigned* st;
};

__device__ __forceinline__ XcdBarrier xcd_barrier_post(unsigned* bar, volatile LAS unsigned* st) {
    XcdBarrier b; b.bar = bar; b.x = xb_xcc_id(); b.st = st;
    if (threadIdx.x == 0) (void)xb_add(&bar[XB_XCNT(b.x)], 1u);
    return b;
}
__device__ __forceinline__ void xcd_barrier_complete(unsigned* bar, unsigned x, unsigned& nloc, unsigned& nx) {
    const unsigned G = gridDim.x * gridDim.y * gridDim.z;
    unsigned sum, cnt, mine, sp = 0u;
    for (;;) {
        sum = 0u; cnt = 0u; mine = 0u;
#pragma unroll
        for (unsigned j = 0; j < 16; ++j) { const unsigned c = xb_ld(&bar[XB_XCNT(j)]); sum += c; cnt += (c > 0u) ? 1u : 0u; mine = (j == x) ? c : mine; }
        if (sum == G) break;
        __builtin_amdgcn_s_sleep(1);
        if ((++sp & 255u) == 0u) { if (xb_ld(&bar[XB_TMO])) break; if (sp > XB_SPIN_CAP) { atomicAdd(&bar[XB_TMO], 1u); break; } }
    }
    nloc = mine > 0u ? mine : 1u; nx = cnt > 0u ? cnt : 1u;
}

__device__ __forceinline__ void xcd_barrier(const XcdBarrier& b) {
    asm volatile("s_waitcnt vmcnt(0)" ::: "memory");
    __syncthreads();
    if (threadIdx.x == 0) {
        unsigned* bar = b.bar;
        __builtin_amdgcn_s_waitcnt(0);
        unsigned nloc = b.st[0], nx = b.st[1];
        if (nloc == 0u) { xcd_barrier_complete(bar, b.x, nloc, nx); b.st[0] = nloc; b.st[1] = nx; }
        const unsigned old = xb_add(&bar[XB_XSUB(b.x)], 1u);
        const unsigned gen = old / nloc;
        if (old + 1u == (gen + 1u) * nloc) {
            __builtin_amdgcn_fence(__ATOMIC_RELEASE, "agent");
            asm volatile("s_waitcnt vmcnt(0)" ::: "memory");
            const unsigned og = xb_add(&bar[XB_TOP], 1u);
            const unsigned tg = og / nx;
            if (og + 1u == (tg + 1u) * nx) xb_add(&bar[XB_TOPGEN], 1u);
            else XB_SPIN(xb_ld(&bar[XB_TOPGEN]) == tg, bar);
            __builtin_amdgcn_fence(__ATOMIC_ACQUIRE, "agent");
            xb_add(&bar[XB_XGEN(b.x)], 1u);
            asm volatile("s_waitcnt vmcnt(0)" ::: "memory");
        } else {
            XB_SPIN(xb_ld(&bar[XB_XGEN(b.x)]) == gen, bar);
            __builtin_amdgcn_fence(__ATOMIC_ACQUIRE, "agent");
            asm volatile("s_waitcnt vmcnt(0)" ::: "memory");
        }
    }
    __syncthreads();
}
struct Args { const float* in[14]; float* out; unsigned char* ws; int ph_lo, ph_hi; };
struct Frame {
    LAS unsigned char* lds; int tid, lane, wave, G, bid;
    const float *xp, *xsm, *w_in, *conv_w, *conv_b, *dtb_f, *dtb_b, *alog_f, *alog_b, *dskip, *norm_ssd, *norm_in, *w_out, *norm_f;
    float* out; unsigned char* ws;
    bf16 *WIN, *WOUT, *MIX, *KB, *VB, *ZA, *XS, *BCR, *XN, *XC, *YF; float *ROPE, *DT, *SSQ_SSD, *SSQ_OUT;
};
__device__ __forceinline__ float wave_sum(float v) {
#pragma unroll
    for (int o = 1; o < 64; o <<= 1) v += __shfl_xor(v, o);
    return v;
}
__device__ __forceinline__ void row_info(int row, int& seq0, int& pos, int& S) {
    if (row < M_P) { S = 4096; pos = row & 4095; seq0 = row & ~4095; } else { const int r = row - M_P; S = 8192; pos = r & 8191; seq0 = M_P + (r & ~8191); }
}
__device__ __forceinline__ int win_dst_row(int s) { if (s < 2048) { const int d = s & 63; return (s & ~63) + (d < 32 ? 2 * d : 2 * (d - 32) + 1); } return s; }
template <bool PERMQ>
__device__ __forceinline__ void transpose_item(const float* W, int K, int N, bf16* WT, const float* kscale, int nscale, LAS float* scr, int item, int lane) {
    const int nblk = N / 32, kb = item / nblk, nb = item % nblk, k0 = 64 * kb, n0 = 32 * nb;
#pragma unroll 8
    for (int i = 0; i < 32; ++i) { const int kk = 2 * i + (lane >> 5); const float sc = (k0 + kk < nscale) ? kscale[k0 + kk] : 1.f;
        scr[kk * 33 + (lane & 31)] = W[(size_t)(k0 + kk) * N + n0 + (lane & 31)] * sc; }
    LDS_WAIT(); asm volatile("" ::: "memory");
    const int c = lane & 7;
#pragma unroll
    for (int j = 0; j < 4; ++j) { const int n = (lane >> 3) + 8 * j; const LAS float* s = scr + (8 * c) * 33 + n;
        v4u o; o.x = pk2(s[0 * 33], s[1 * 33]); o.y = pk2(s[2 * 33], s[3 * 33]); o.z = pk2(s[4 * 33], s[5 * 33]); o.w = pk2(s[6 * 33], s[7 * 33]);
        const int dst = PERMQ ? win_dst_row(n0 + n) : (n0 + n);
        *(GAS v4u*)(WT + (size_t)dst * K + k0 + 8 * c) = o; }
    LDS_WAIT(); asm volatile("" ::: "memory");
}
__device__ __forceinline__ void p0_prologue(Frame& F) {
    LAS float* scr = (LAS float*)(F.lds + RING_OFF + F.wave * 16384);
    const int gw = F.bid * NWAVES + F.wave, NGW = F.G * NWAVES;
    constexpr int I_IN = (DM / 64) * (NPROJ / 32), I_OUT = (KOUT / 64) * (DM / 32);
    for (int it = gw; it < I_IN + I_OUT; it += NGW) {
        if (it < I_IN) transpose_item<true>(F.w_in, DM, NPROJ, F.WIN, F.norm_in, DM, scr, it, F.lane);
        else transpose_item<false>(F.w_out, KOUT, DM, F.WOUT, F.norm_ssd, 1024, scr, it - I_IN, F.lane);
    }
    {
        const int gt = F.bid * NT + F.tid, NGT = F.G * NT; constexpr int NV = (NPAD - NPROJ) * DM / 8;
        GAS v4u* z = (GAS v4u*)(F.WIN + (size_t)NPROJ * DM);
        for (int i = gt; i < NV; i += NGT) z[i] = (v4u){0u, 0u, 0u, 0u};
        for (int i = gt; i < 8192 * 32; i += NGT) {
            const int pos = i >> 5, j = i & 31; double inv = 1.0; for (int q = 0; q < j; ++q) inv *= 0.7498942093324558273;
            const double ang = (double)pos * inv; const double k = rint(ang * 0.15915494309189533577); double r = ang - k * 6.283185307179586476925;
            const double qd = rint(r * 0.63661977236758134308); const double t = r - qd * 1.57079632679489661923; const double t2 = t * t;
            double sn = t * (1.0 + t2 * (-1.0 / 6 + t2 * (1.0 / 120 + t2 * (-1.0 / 5040 + t2 * (1.0 / 362880 + t2 * (-1.0 / 39916800 + t2 * (1.0 / 6227020800.0)))))));
            double cs = 1.0 + t2 * (-0.5 + t2 * (1.0 / 24 + t2 * (-1.0 / 720 + t2 * (1.0 / 40320 + t2 * (-1.0 / 3628800 + t2 * (1.0 / 479001600.0 + t2 * (-1.0 / 87178291200.0)))))));
            const int qi = ((int)qd) & 3; double c, s;
            if (qi == 0) { c = cs; s = sn; } else if (qi == 1) { c = -sn; s = cs; } else if (qi == 2) { c = -cs; s = -sn; } else { c = sn; s = -cs; }
            F.ROPE[2 * i] = (float)c; F.ROPE[2 * i + 1] = (float)s;
        }
    }
    for (int m = gw; m < M; m += NGW) {
        const float* xrow = m < M_P ? F.xp + (size_t)m * DM : F.xsm + (size_t)(m - M_P) * DM;
        const GAS f32x4* xr = (const GAS f32x4*)xrow + F.lane; f32x4 v[4]; float s = 0.f;
#pragma unroll
        for (int j = 0; j < 4; ++j) { v[j] = xr[64 * j]; s += (v[j].x * v[j].x + v[j].y * v[j].y) + (v[j].z * v[j].z + v[j].w * v[j].w); }
        const float rs = 1.f / sqrtf(wave_sum(s) * (1.f / DM) + EPS);
        GAS unsigned long long* o8 = (GAS unsigned long long*)(F.XN + (size_t)m * DM) + F.lane;
#pragma unroll
        for (int j = 0; j < 4; ++j) o8[64 * j] = (unsigned long long)pk2(v[j].x * rs, v[j].y * rs) | ((unsigned long long)pk2(v[j].z * rs, v[j].w * rs) << 32);
    }
}
__device__ __forceinline__ void nv_conv(Frame& F) {
    const int gt = F.bid * NT + F.tid, NGT = F.G * NT;
    for (int i = gt; i < M * 192; i += NGT) {
        const int row = i / 192, c8 = (i % 192) * 8; int seq0, pos, S; row_info(row, seq0, pos, S);
        float a[8];
#pragma unroll
        for (int e = 0; e < 8; ++e) a[e] = F.conv_b[c8 + e];
#pragma unroll
        for (int j = 0; j < 5; ++j) { const int p2 = pos + j - 2; if (p2 < 0 || p2 >= S) continue; const int r2 = seq0 + p2;
            const v4u w = c8 < 1024 ? *(const v4u*)(F.XS + (size_t)r2 * 1024 + c8) : *(const v4u*)(F.BCR + (size_t)r2 * 512 + (c8 - 1024));
            const float* cw = F.conv_w + j * 1536 + c8;
            a[0] += cw[0] * bflo(w.x); a[1] += cw[1] * bfhi(w.x); a[2] += cw[2] * bflo(w.y); a[3] += cw[3] * bfhi(w.y);
            a[4] += cw[4] * bflo(w.z); a[5] += cw[5] * bfhi(w.z); a[6] += cw[6] * bflo(w.w); a[7] += cw[7] * bfhi(w.w); }
#pragma unroll
        for (int e = 0; e < 8; ++e) a[e] = silu_f(a[e]);
        v4u o; o.x = pk2(a[0], a[1]); o.y = pk2(a[2], a[3]); o.z = pk2(a[4], a[5]); o.w = pk2(a[6], a[7]);
        *(v4u*)(F.XC + (size_t)row * 1536 + c8) = o;
    }
}
__device__ __forceinline__ void nv_ssd_chain(Frame& F, int item, int dir) {
    const int b = item >> 4, head = item & 15, g = head >> 3;
    const int S = b < 4 ? 4096 : 8192, seq0 = b < 4 ? b * 4096 : M_P + (b - 4) * 8192;
    LAS float* Bs = (LAS float*)(F.lds); LAS float* Cs = Bs + 32 * 128; LAS float* xs = Cs + 32 * 128; LAS float* dtv = xs + 32 * 64; LAS float* dAv = dtv + 32; LAS float* yp = dAv + 32;
    const int p = F.tid & 63, ng = F.wave;
    const float A = -__expf(dir ? F.alog_b[head] : F.alog_f[head]); const float dtb = dir ? F.dtb_b[head] : F.dtb_f[head]; const float Dh = F.dskip[head];
    float St[16];
#pragma unroll
    for (int j = 0; j < 16; ++j) St[j] = 0.f;
    for (int blk = 0; blk < S / 32; ++blk) {
        __syncthreads();
        for (int e = F.tid; e < 32 * 128; e += NT) { const int i = e >> 7, n = e & 127; const int t = dir ? S - 1 - (blk * 32 + i) : blk * 32 + i;
            const bf16* r = F.XC + (size_t)(seq0 + t) * 1536; Bs[e] = bf2f(r[1024 + g * 128 + n]); Cs[e] = bf2f(r[1280 + g * 128 + n]); }
        for (int e = F.tid; e < 32 * 64; e += NT) { const int i = e >> 6, pp = e & 63; const int t = dir ? S - 1 - (blk * 32 + i) : blk * 32 + i;
            xs[e] = bf2f(F.XC[(size_t)(seq0 + t) * 1536 + head * 64 + pp]); }
        if (F.tid < 32) { const int t = dir ? S - 1 - (blk * 32 + F.tid) : blk * 32 + F.tid; const float raw = F.DT[(size_t)(seq0 + t) * 32 + dir * 16 + head] + dtb;
            const float dt = raw > 20.f ? raw : log1pf(__expf(raw)); dtv[F.tid] = dt; dAv[F.tid] = __expf(dt * A); }
        __syncthreads();
        for (int i = 0; i < 32; ++i) {
            const float xdt = xs[i * 64 + p] * dtv[i], da = dAv[i]; float y = 0.f;
#pragma unroll
            for (int j = 0; j < 16; ++j) { const int n = ng * 16 + j; St[j] = St[j] * da + xdt * Bs[i * 128 + n]; y += Cs[i * 128 + n] * St[j]; }
            yp[(i * 8 + ng) * 64 + p] = y;
        }
        __syncthreads();
        for (int e = F.tid; e < 2048; e += NT) { const int i = e >> 6, pp = e & 63; float y = 0.f;
#pragma unroll
            for (int q = 0; q < 8; ++q) y += yp[(i * 8 + q) * 64 + pp];
            const int t = dir ? S - 1 - (blk * 32 + i) : blk * 32 + i; const size_t row = (size_t)(seq0 + t);
            if (dir == 0) F.YF[row * 1024 + head * 64 + pp] = (bf16)f2bf(y);
            else { const float tot = y + bf2f(F.YF[row * 1024 + head * 64 + pp]) + Dh * xs[i * 64 + pp];
                bf16* zp = F.MIX + row * 2048 + head * 64 + pp; const float val = tot * silu_f(bf2f(*zp)); *zp = (bf16)f2bf(val);
                const float sq = wave_sum(val * val); if (F.lane == 0) atomicAdd(F.SSQ_SSD + row, sq); }
        }
    }
}
__device__ __forceinline__ void nv_attn_unit(Frame& F, int unit) {
    const int idx = unit * NT + F.tid; const int head = idx / M, row = idx % M; int seq0, pos, S; row_info(row, seq0, pos, S);
    float q[64], o[64];
    { const v4u* qp = (const v4u*)(F.MIX + (size_t)row * 2048 + 1024 + head * 64);
#pragma unroll
      for (int c = 0; c < 8; ++c) { const v4u w = qp[c]; q[8 * c] = bflo(w.x); q[8 * c + 1] = bfhi(w.x); q[8 * c + 2] = bflo(w.y); q[8 * c + 3] = bfhi(w.y); q[8 * c + 4] = bflo(w.z); q[8 * c + 5] = bfhi(w.z); q[8 * c + 6] = bflo(w.w); q[8 * c + 7] = bfhi(w.w); } }
#pragma unroll
    for (int d = 0; d < 64; ++d) o[d] = 0.f;
    float mx = -INFINITY, l = 0.f;
    for (int pat = 0; pat < 3; ++pat) { const int dil = pat == 0 ? 1 : (pat == 1 ? 4 : 16);
        for (int mm = -64; mm <= 64; ++mm) { const int p2 = pos + mm * dil; if (p2 < 0 || p2 >= S) continue; const size_t r2 = (size_t)(seq0 + p2);
            const v4u* kp = (const v4u*)(F.KB + r2 * 1024 + head * 64); float s = 0.f;
#pragma unroll
            for (int c = 0; c < 8; ++c) { const v4u w = kp[c]; s += q[8 * c] * bflo(w.x) + q[8 * c + 1] * bfhi(w.x) + q[8 * c + 2] * bflo(w.y) + q[8 * c + 3] * bfhi(w.y) + q[8 * c + 4] * bflo(w.z) + q[8 * c + 5] * bfhi(w.z) + q[8 * c + 6] * bflo(w.w) + q[8 * c + 7] * bfhi(w.w); }
            if (s > mx) { const float f = exp2f(mx - s); l *= f;
#pragma unroll
                for (int d = 0; d < 64; ++d) o[d] *= f;
                mx = s; }
            const float pw = exp2f(s - mx); l += pw;
            const v4u* vp = (const v4u*)(F.VB + r2 * 1024 + head * 64);
#pragma unroll
            for (int c = 0; c < 8; ++c) { const v4u w = vp[c]; o[8 * c] += pw * bflo(w.x); o[8 * c + 1] += pw * bfhi(w.x); o[8 * c + 2] += pw * bflo(w.y); o[8 * c + 3] += pw * bfhi(w.y); o[8 * c + 4] += pw * bflo(w.z); o[8 * c + 5] += pw * bfhi(w.z); o[8 * c + 6] += pw * bflo(w.w); o[8 * c + 7] += pw * bfhi(w.w); }
        } }
    const float il = 1.f / l; const v4u* zp = (const v4u*)(F.ZA + (size_t)row * 1024 + head * 64); v4u* op = (v4u*)(F.MIX + (size_t)row * 2048 + 1024 + head * 64);
#pragma unroll
    for (int c = 0; c < 8; ++c) { const v4u z = zp[c]; v4u w;
        w.x = pk2(o[8 * c] * il * silu_f(bflo(z.x)), o[8 * c + 1] * il * silu_f(bfhi(z.x))); w.y = pk2(o[8 * c + 2] * il * silu_f(bflo(z.y)), o[8 * c + 3] * il * silu_f(bfhi(z.y)));
        w.z = pk2(o[8 * c + 4] * il * silu_f(bflo(z.z)), o[8 * c + 5] * il * silu_f(bfhi(z.z))); w.w = pk2(o[8 * c + 6] * il * silu_f(bflo(z.w)), o[8 * c + 7] * il * silu_f(bfhi(z.w)));
        op[c] = w; }
}
__device__ __forceinline__ void nv_ssd_norm(Frame& F) {
    const int gt = F.bid * NT + F.tid, NGT = F.G * NT;
    for (int i = gt; i < M * 128; i += NGT) { const int row = i >> 7, c8 = (i & 127) * 8; const float rs = 1.f / sqrtf(F.SSQ_SSD[row] * (1.f / 1024.f) + EPS);
        v4u* p = (v4u*)(F.MIX + (size_t)row * 2048 + c8); v4u w = *p;
        w.x = pk2(bflo(w.x) * rs, bfhi(w.x) * rs); w.y = pk2(bflo(w.y) * rs, bfhi(w.y) * rs); w.z = pk2(bflo(w.z) * rs, bfhi(w.z) * rs); w.w = pk2(bflo(w.w) * rs, bfhi(w.w) * rs); *p = w; }
}
__device__ __forceinline__ void final_norm(Frame& F) {
    const int gt = F.bid * NT + F.tid, NGT = F.G * NT;
    for (int i = gt; i < M * 256; i += NGT) { const int row = i >> 8, c4 = (i & 255) * 4; const float rs = 1.f / sqrtf(F.SSQ_OUT[row] * (1.f / 1024.f) + EPS);
        f32x4* p = (f32x4*)(F.out + (size_t)row * 1024 + c4); const f32x4 g = *(const f32x4*)(F.norm_f + c4); *p = *p * rs * g; }
}
#ifndef MK_ONE_LAUNCH
#define MK_ONE_LAUNCH 1
#endif
constexpr int NPHASE = 8;
__global__ void __launch_bounds__(NT, 2) hybrid_fwd(Args args) {
    extern __shared__ __attribute__((aligned(16))) unsigned char lds[];
    Frame F;
    F.lds = (LAS unsigned char*)lds; F.tid = threadIdx.x; F.lane = F.tid & 63; F.wave = __builtin_amdgcn_readfirstlane(F.tid >> 6); F.G = gridDim.x; F.bid = blockIdx.x;
    F.xp = args.in[0]; F.xsm = args.in[1]; F.w_in = args.in[2]; F.conv_w = args.in[3]; F.conv_b = args.in[4]; F.dtb_f = args.in[5]; F.dtb_b = args.in[6];
    F.alog_f = args.in[7]; F.alog_b = args.in[8]; F.dskip = args.in[9]; F.norm_ssd = args.in[10]; F.norm_in = args.in[11]; F.w_out = args.in[12]; F.norm_f = args.in[13];
    F.out = args.out; F.ws = args.ws; unsigned char* ws = args.ws;
    F.WIN = (bf16*)(ws + WS_WIN); F.WOUT = (bf16*)(ws + WS_WOUT); F.ROPE = (float*)(ws + WS_ROPE); F.DT = (float*)(ws + WS_DT); F.MIX = (bf16*)(ws + WS_MIX);
    F.KB = (bf16*)(ws + WS_K); F.VB = (bf16*)(ws + WS_V); F.ZA = (bf16*)(ws + WS_ZA); F.XS = (bf16*)(ws + WS_XS); F.BCR = (bf16*)(ws + WS_BCR);
    F.XN = (bf16*)args.out;
    F.XC = (bf16*)args.out; F.YF = (bf16*)(ws + WS_FREE);
    F.SSQ_SSD = (float*)(ws + WS_CTL + CTL_SSQ_SSD); F.SSQ_OUT = (float*)(ws + WS_CTL + CTL_SSQ_OUT);
    for (int u = F.tid; u < (LDS_BYTES - LDSCTL_OFF) / 4; u += NT) ((LAS unsigned*)(F.lds + LDSCTL_OFF))[u] = 0u;
    __syncthreads();
    XcdBarrier bar; bar.bar = (unsigned*)(ws + WS_CTL) + CW_BAR; bar.x = 0; bar.st = nullptr;
    if (MK_ONE_LAUNCH) bar = xcd_barrier_post((unsigned*)(ws + WS_CTL) + CW_BAR, (volatile LAS unsigned*)(F.lds + MISC_OFF) + 8);
    const int lo = args.ph_lo, hi = args.ph_hi;
#define IN(k) (lo <= (k) && (k) < hi)
#define SEAM(k) do { if (IN(k) && IN((k) + 1)) xcd_barrier(bar); } while (0)
    if (IN(0)) { p0_prologue(F); SEAM(0); }
    if (IN(1)) {
        pg8::Gemm g{F.XN, F.WIN, M, NPAD, DM}; pg8::StaticOrder S; S.init(M, NPAD, F.G, F.bid);
        pg8::EpiInProj E{F.MIX, F.KB, F.VB, F.ZA, F.XS, F.BCR, F.DT, F.ROPE};
        pg8::gemm_phase<pg8::EpiInProj, pg8::StaticOrder, true, true>(F.lds + RING_OFF, g, S, E);
        SEAM(1);
    }
    if (IN(2)) { nv_conv(F); SEAM(2); }
    if (IN(3)) {
        if (F.bid < 128) nv_ssd_chain(F, F.bid, 0);
        __syncthreads();
        for (int u = F.bid; u < M * 16 / NT; u += F.G) nv_attn_unit(F, u);
        SEAM(3);
    }
    if (IN(4)) { if (F.bid < 128) nv_ssd_chain(F, F.bid, 1); SEAM(4); }
    if (IN(5)) { nv_ssd_norm(F); SEAM(5); }
    if (IN(6)) {
        pg8::Gemm g{F.MIX, F.WOUT, M, DM, KOUT}; pg8::StaticOrder S; S.init(M, DM, F.G, F.bid);
        pg8::EpiOutProj E{F.xp, F.xsm, F.out, F.SSQ_OUT};
        pg8::gemm_phase<pg8::EpiOutProj, pg8::StaticOrder, true, true>(F.lds + RING_OFF, g, S, E);
        SEAM(6);
    }
    if (IN(7)) final_norm(F);
#undef IN
#undef SEAM
}
extern "C" void kernel_launch(void* const* d_in, const int* in_sizes, int n_in, void* d_out, int out_size, void* d_ws, size_t ws_size, hipStream_t stream) {
    static int grid = 0;
    if (grid == 0) {
        if (n_in != 14 || out_size != M * DM || ws_size < WS_END) { fprintf(stderr, "kernel_launch: unexpected problem: n_in %d out %d ws %zu\n", n_in, out_size, ws_size); grid = -1; return; }
        int dev = 0, cus = 0, per_cu = 0;
        if (hipGetDevice(&dev) != hipSuccess || hipDeviceGetAttribute(&cus, hipDeviceAttributeMultiprocessorCount, dev) != hipSuccess) { grid = -1; return; }
        if (hipFuncSetAttribute((const void*)hybrid_fwd, hipFuncAttributeMaxDynamicSharedMemorySize, LDS_BYTES) != hipSuccess) { fprintf(stderr, "kernel_launch: hipFuncSetAttribute failed\n"); grid = -1; return; }
        if (hipOccupancyMaxActiveBlocksPerMultiprocessor(&per_cu, (const void*)hybrid_fwd, NT, LDS_BYTES) != hipSuccess || per_cu < 1) { fprintf(stderr, "kernel_launch: occupancy query says %d\n", per_cu); per_cu = 1; }
        (void)hipGetLastError();
        grid = cus;
    }
    if (grid < 0) return;
    (void)hipMemsetAsync((char*)d_ws + WS_CTL, 0, CTL_ZERO_BYTES, stream);
    Args a{};
    for (int i = 0; i < 14; ++i) a.in[i] = (const float*)d_in[i];
    a.out = (float*)d_out; a.ws = (unsigned char*)d_ws;
#if MK_ONE_LAUNCH
    a.ph_lo = 0; a.ph_hi = NPHASE;
    hipLaunchKernelGGL(hybrid_fwd, dim3(grid), dim3(NT), LDS_BYTES, stream, a);
#else
    for (int p = 0; p < NPHASE; ++p) { a.ph_lo = p; a.ph_hi = p + 1; hipLaunchKernelGGL(hybrid_fwd, dim3(grid), dim3(NT), LDS_BYTES, stream, a); }
#endif
}
```

```cpp
#include <hip/hip_runtime.h>
#include <cstdio>
#include <cstdint>
#include <cmath>
namespace pg8 {
#define PG8_LAS __attribute__((address_space(3)))
typedef unsigned short bf16_t;
typedef short bf16x8 __attribute__((ext_vector_type(8)));
typedef float f32x4 __attribute__((ext_vector_type(4)));
typedef unsigned u32x4 __attribute__((ext_vector_type(4)));
constexpr int BM = 256, BK = 64, HALF = 128, HTB = HALF * BK * 2  , STAGE_BYTES = 8 * HTB, NXCD = 8, WGM = 8;

__host__ __device__ __forceinline__ int lds_byte(int r, int c) { const int st = (r >> 4) * 2 + (c >> 5), rr = r & 15, cc = c & 31, ob = rr * 64 + cc * 2; return st * 1024 + (ob ^ (((ob >> 9) & 1) << 5)); }
__host__ __device__ __forceinline__ void stage_rc(int b, int& R, int& C) { const int st = b / 1024, sb = b % 1024, swz = sb ^ (((sb >> 9) & 1) << 5); R = (st >> 1) * 16 + swz / 64; C = (st & 1) * 32 + (swz % 64) / 2; }
__host__ __device__ __forceinline__ int perm32(int rho) { const int n = rho >> 4, i = rho & 15; return 8 * (i >> 2) + 4 * n + (i & 3); }

struct Unit { int pm, pn; };
struct Gemm { const bf16_t* A; const bf16_t* Bt; int M, N, K; };

struct StaticOrder {
    int nM, nN, nwg, G, c;
    __host__ __device__ void init(int M, int N, int G_, int c_) { nM = M / BM; nN = N / BM; nwg = nM * nN; G = G_; c = c_; }
    __host__ __device__ bool next(int i, Unit& u) const {
        const long L = (long)i * G + c; if (L >= nwg) return false;
        int wgid = (int)L; { const int q = nwg / NXCD, r = nwg % NXCD, xcd = wgid % NXCD, off = wgid / NXCD; wgid = (xcd < r ? xcd * (q + 1) : r * (q + 1) + (xcd - r) * q) + off; }
        const int nig = WGM * nN, gid = wgid / nig, fm = gid * WGM, gsz = (nM - fm) < WGM ? (nM - fm) : WGM;
        u.pm = fm + ((wgid % nig) % gsz); u.pn = (wgid % nig) / gsz; return true;
    }
    __device__ __forceinline__ void a_ready(const Unit&) const {}
    __device__ __forceinline__ void done(const Unit&) const {}
};

__device__ __forceinline__ unsigned cvt_pk_bf16(float lo, float hi) { unsigned r; asm volatile("v_cvt_pk_bf16_f32 %0, %1, %2" : "=v"(r) : "v"(lo), "v"(hi)); return r; }
typedef float f32x2 __attribute__((ext_vector_type(2)));
__device__ __forceinline__ f32x2 gelu_pk(f32x2 v) {
    const f32x2 av = __builtin_elementwise_abs(v), d = av * 0.2316418882f + 1.0f;
    f32x2 t; t.x = __builtin_amdgcn_rcpf(d.x); t.y = __builtin_amdgcn_rcpf(d.y);
    f32x2 q = t * 0.5307027145f + (-0.7265760135f); q = q * t + 0.7107068705f; q = q * t + (-0.142248368f); q = q * t + 0.127414796f; q = q * t;
    const f32x2 s = (v * v) * (-0.72134752044f);
    f32x2 e; e.x = __builtin_amdgcn_exp2f(s.x); e.y = __builtin_amdgcn_exp2f(s.y);
    const f32x2 m = v * (q * e), r = v - m;
    f32x2 o; o.x = v.x < 0.f ? m.x : r.x; o.y = v.y < 0.f ? m.y : r.y; return o;
}

struct EpiInProj {
    static constexpr bool PERM = true, AFTER_DRAIN = false;
    bf16_t *MIX, *KB, *VB, *ZA, *XS, *BCR; float* DT; const float* rope;
    __device__ __forceinline__ void operator()(const f32x4 (&acc)[2][2][4][2], const Unit& u, int wr, int wc, int fr, int fq) const {
        const int row0 = u.pm * BM + wr * 64 + fr; const int pn = u.pn;
        if (pn == 26) {
            if (wc == 0) {
#pragma unroll
                for (int ai = 0; ai < 2; ++ai)
#pragma unroll
                    for (int m = 0; m < 4; ++m) { float* rp = DT + (size_t)(row0 + ai * HALF + m * 16) * 32 + 8 * fq;
                        *(f32x4*)rp = acc[ai][0][m][0]; *(f32x4*)(rp + 4) = acc[ai][0][m][1]; }
            }
            return;
        }
        bf16_t* base; int ldc, colt, mode = 0;
        if (pn < 4)       { base = MIX + 1024; ldc = 2048; colt = pn * 256; mode = 1; }
        else if (pn < 8)  { base = KB;  ldc = 1024; colt = (pn - 4) * 256; mode = 2; }
        else if (pn < 12) { base = VB;  ldc = 1024; colt = (pn - 8) * 256; }
        else if (pn < 16) { base = ZA;  ldc = 1024; colt = (pn - 12) * 256; }
        else if (pn < 20) { base = MIX; ldc = 2048; colt = (pn - 16) * 256; }
        else if (pn < 24) { base = XS;  ldc = 1024; colt = (pn - 20) * 256; }
        else              { base = BCR; ldc = 512;  colt = (pn - 24) * 256; }
        const int col0 = colt + wc * 32 + 8 * fq;
        const float qs = (mode == 1) ? 0.125f * 1.4426950408889634f : 1.0f;
        const int j0 = (wc & 1) * 16 + 4 * fq;
#pragma unroll
        for (int ai = 0; ai < 2; ++ai)
#pragma unroll
            for (int m = 0; m < 4; ++m) {
                const int row = row0 + ai * HALF + m * 16;
                bf16_t* rowp = base + (size_t)row * ldc + col0;
                f32x4 cs0 = {1.f, 0.f, 1.f, 0.f}, cs1 = {1.f, 0.f, 1.f, 0.f};
                if (mode != 0) { const int pos = row < 16384 ? (row & 4095) : ((row - 16384) & 8191);
                    const float* rp = rope + ((size_t)pos * 32 + j0) * 2; cs0 = *(const f32x4*)rp; cs1 = *(const f32x4*)(rp + 4); }
#pragma unroll
                for (int bj = 0; bj < 2; ++bj) {
                    f32x4 v0 = acc[ai][bj][m][0], v1 = acc[ai][bj][m][1];
                    if (mode != 0) {
                        f32x4 a, b;
                        a[0] = v0[0] * cs0[0] - v0[1] * cs0[1]; a[1] = v0[1] * cs0[0] + v0[0] * cs0[1];
                        a[2] = v0[2] * cs0[2] - v0[3] * cs0[3]; a[3] = v0[3] * cs0[2] + v0[2] * cs0[3];
                        b[0] = v1[0] * cs1[0] - v1[1] * cs1[1]; b[1] = v1[1] * cs1[0] + v1[0] * cs1[1];
                        b[2] = v1[2] * cs1[2] - v1[3] * cs1[3]; b[3] = v1[3] * cs1[2] + v1[2] * cs1[3];
                        v0 = a * qs; v1 = b * qs;
                    }
                    u32x4 w; w.x = cvt_pk_bf16(v0[0], v0[1]); w.y = cvt_pk_bf16(v0[2], v0[3]); w.z = cvt_pk_bf16(v1[0], v1[1]); w.w = cvt_pk_bf16(v1[2], v1[3]);
                    *(u32x4*)(rowp + bj * HALF) = w;
                }
            }
    }
};
struct EpiOutProj {
    static constexpr bool PERM = false, AFTER_DRAIN = false;
    const float* xp; const float* xs; float* out; float* ssq;
    __device__ __forceinline__ void operator()(const f32x4 (&acc)[2][2][4][2], const Unit& u, int wr, int wc, int fr, int fq) const {
        const int row0 = u.pm * BM + wr * 64 + fr; const int col0 = u.pn * BM + wc * 32 + 4 * fq;
#pragma unroll
        for (int ai = 0; ai < 2; ++ai)
#pragma unroll
            for (int m = 0; m < 4; ++m) {
                const int row = row0 + ai * HALF + m * 16;
                const float* xr = (row < 16384 ? xp + (size_t)row * 1024 : xs + (size_t)(row - 16384) * 1024) + col0;
                float* orow = out + (size_t)row * 1024 + col0; float s = 0.f;
#pragma unroll
                for (int bj = 0; bj < 2; ++bj)
#pragma unroll
                    for (int n = 0; n < 2; ++n) { const f32x4 o = *(const f32x4*)(xr + bj * HALF + n * 16) + acc[ai][bj][m][n];
                        *(f32x4*)(orow + bj * HALF + n * 16) = o; s += (o[0] * o[0] + o[1] * o[1]) + (o[2] * o[2] + o[3] * o[3]); }
                s += __shfl_xor(s, 16); s += __shfl_xor(s, 32);
                if (fq == 0) atomicAdd(ssq + row, s);
            }
    }
};
template <class Epi, class Sched, bool ALIGN_EPI = false, bool SP2 = false>
__device__ __forceinline__ void gemm_phase(PG8_LAS unsigned char* lds, const Gemm g, const Sched& S, const Epi& E) {
    const int tid = threadIdx.x, wid = __builtin_amdgcn_readfirstlane(tid >> 6), lane = tid & 63, wr = wid >> 2, wc = wid & 3, fr = lane & 15, fq = lane >> 4;
    const int K = g.K, nt = K / BK;
    unsigned voffA[2], voffB[2];
#pragma unroll
    for (int i = 0; i < 2; ++i) { int R, C; stage_rc(tid * 16 + i * 8192, R, C); const int Rb = Epi::PERM ? ((R & ~31) + perm32(R & 31)) : R;
        voffA[i] = (unsigned)(R * K + C) * 2u; voffB[i] = (unsigned)(Rb * K + C) * 2u; }
    const size_t kstep = (size_t)(BK * 2);
    const size_t hstep = (size_t)HALF * K * 2;
    const size_t tstep = 2 * hstep;
    const unsigned ldsw = (unsigned)wid * 1024u;
    const int aoff = lds_byte(wr * 64 + fr, fq * 8), boff = lds_byte(wc * 32 + fr, fq * 8);
#define PG8_SA(b, h) (((b) * 2 + (h)) * HTB)
#define PG8_SB(b, h) ((4 + (b) * 2 + (h)) * HTB)
#define PG8_STAGE(bufoff, gbase, voff) do { _Pragma("unroll") for (int _i = 0; _i < 2; ++_i) \
        __builtin_amdgcn_global_load_lds((const unsigned*)((const char*)(gbase) + (voff)[_i]), (PG8_LAS unsigned*)(lds + (bufoff) + ldsw + _i * 8192), 16, 0, 0); } while (0)
#define PG8_LDA(dst, b, h) do { _Pragma("unroll") for (int m = 0; m < 4; ++m) _Pragma("unroll") for (int k = 0; k < 2; ++k) dst[m][k] = *(const PG8_LAS bf16x8*)(lds + PG8_SA(b, h) + aoff + m * 2048 + k * 1024); } while (0)
#define PG8_LDB(dst, b, h) do { _Pragma("unroll") for (int n = 0; n < 2; ++n) _Pragma("unroll") for (int k = 0; k < 2; ++k) dst[n][k] = *(const PG8_LAS bf16x8*)(lds + PG8_SB(b, h) + boff + n * 2048 + k * 1024); } while (0)
#define PG8_MMA(ai, bj, At, Bt) do { __builtin_amdgcn_s_setprio(1); _Pragma("unroll") for (int m = 0; m < 4; ++m) _Pragma("unroll") for (int n = 0; n < 2; ++n) _Pragma("unroll") for (int k = 0; k < 2; ++k) \
        acc[ai][bj][m][n] = __builtin_amdgcn_mfma_f32_16x16x32_bf16(Bt[n][k], At[m][k], acc[ai][bj][m][n], 0, 0, 0); __builtin_amdgcn_s_setprio(0); } while (0)
#define PG8_WAIT_V(n) asm volatile("s_waitcnt vmcnt(" #n ")" ::: "memory")
#define PG8_WAIT_L(n) asm volatile("s_waitcnt lgkmcnt(" #n ")" ::: "memory")
#define PG8_BAR __builtin_amdgcn_s_barrier()
#define PG8_SCHED __builtin_amdgcn_sched_barrier(0)
    Unit cur, nxt; int ui = 0;
    if (!S.next(0, cur)) return;
    f32x4 acc[2][2][4][2];
#pragma unroll
    for (int a = 0; a < 2; ++a)
#pragma unroll
        for (int b = 0; b < 2; ++b)
#pragma unroll
            for (int m = 0; m < 4; ++m)
#pragma unroll
                for (int n = 0; n < 2; ++n) acc[a][b][m][n] = (f32x4){0.f, 0.f, 0.f, 0.f};
    bf16x8 At[4][2], B0[2][2], B1[2][2];
    const char* cA = (const char*)g.A + (size_t)cur.pm * tstep; const char* cB = (const char*)g.Bt + (size_t)cur.pn * tstep;
    S.a_ready(cur);
    if constexpr (SP2) {
        PG8_STAGE(PG8_SB(0, 0), cB, voffB); PG8_STAGE(PG8_SB(0, 1), cB + hstep, voffB); PG8_STAGE(PG8_SA(0, 0), cA, voffA); PG8_STAGE(PG8_SA(0, 1), cA + hstep, voffA);
        if (wr == 1) PG8_BAR;
        PG8_WAIT_V(2); PG8_BAR;
        PG8_STAGE(PG8_SB(1, 0), cB + kstep, voffB); PG8_STAGE(PG8_SA(1, 0), cA + kstep, voffA); PG8_STAGE(PG8_SB(1, 1), cB + hstep + kstep, voffB);
        PG8_WAIT_V(6); PG8_BAR;
    } else {
        PG8_STAGE(PG8_SB(0, 0), cB, voffB); PG8_STAGE(PG8_SA(0, 0), cA, voffA); PG8_STAGE(PG8_SB(0, 1), cB + hstep, voffB); PG8_STAGE(PG8_SA(0, 1), cA + hstep, voffA);
        if (wr == 1) PG8_BAR;
        PG8_WAIT_V(4); PG8_BAR;
        PG8_STAGE(PG8_SB(1, 0), cB + kstep, voffB); PG8_STAGE(PG8_SA(1, 0), cA + kstep, voffA); PG8_STAGE(PG8_SB(1, 1), cB + hstep + kstep, voffB);
        PG8_WAIT_V(6); PG8_BAR;
    }
    for (;;) {
        const bool has_next = S.next(ui + 1, nxt);
        const char* nA = has_next ? (const char*)g.A + (size_t)nxt.pm * tstep : cA; const char* nB = has_next ? (const char*)g.Bt + (size_t)nxt.pn * tstep : cB;
        for (int t = 0; t < nt; t += 2) {
            const bool last = (t == nt - 2);
            const char* a1 = cA + (size_t)(t + 1) * kstep;
            const char* a2 = last ? nA : cA + (size_t)(t + 2) * kstep; const char* b2 = last ? nB : cB + (size_t)(t + 2) * kstep;
            const char* a3 = a2 + kstep; const char* b3 = b2 + kstep;
            if (last && has_next) S.a_ready(nxt);
            if constexpr (SP2) {
            PG8_LDB(B0, 0, 0); PG8_LDB(B1, 0, 1); PG8_SCHED; PG8_LDA(At, 0, 0); PG8_STAGE(PG8_SA(1, 1), a1 + hstep, voffA);
            PG8_WAIT_V(8); PG8_WAIT_L(0); PG8_BAR; PG8_MMA(0, 0, At, B0); PG8_MMA(0, 1, At, B1); PG8_BAR; PG8_SCHED;
            PG8_LDA(At, 0, 1); PG8_STAGE(PG8_SB(0, 0), b2, voffB); PG8_STAGE(PG8_SB(0, 1), b2 + hstep, voffB); PG8_STAGE(PG8_SA(0, 0), a2, voffA);
            PG8_WAIT_V(8); PG8_WAIT_L(0); PG8_BAR; PG8_MMA(1, 0, At, B0); PG8_MMA(1, 1, At, B1); PG8_BAR; PG8_SCHED;
            PG8_LDB(B0, 1, 0); PG8_LDB(B1, 1, 1); PG8_SCHED; PG8_LDA(At, 1, 0); PG8_STAGE(PG8_SA(0, 1), a2 + hstep, voffA);
            PG8_WAIT_V(8); PG8_WAIT_L(0); PG8_BAR; PG8_MMA(0, 0, At, B0); PG8_MMA(0, 1, At, B1); PG8_BAR; PG8_SCHED;
            PG8_LDA(At, 1, 1); PG8_STAGE(PG8_SB(1, 0), b3, voffB); PG8_STAGE(PG8_SB(1, 1), b3 + hstep, voffB); PG8_STAGE(PG8_SA(1, 0), a3, voffA);
            PG8_WAIT_V(8); PG8_WAIT_L(0); PG8_BAR; PG8_MMA(1, 0, At, B0); PG8_MMA(1, 1, At, B1); PG8_BAR; PG8_SCHED;
            } else {
            PG8_LDB(B0, 0, 0); PG8_SCHED; PG8_LDA(At, 0, 0); PG8_STAGE(PG8_SA(1, 1), a1 + hstep, voffA);
            PG8_WAIT_L(8); PG8_BAR; PG8_WAIT_L(0); PG8_MMA(0, 0, At, B0); PG8_BAR; PG8_SCHED;
            PG8_LDB(B1, 0, 1); PG8_STAGE(PG8_SB(0, 0), b2, voffB);
            PG8_BAR; PG8_WAIT_L(0); PG8_MMA(0, 1, At, B1); PG8_BAR;
            PG8_LDA(At, 0, 1); PG8_STAGE(PG8_SA(0, 0), a2, voffA);
            PG8_BAR; PG8_WAIT_L(0); PG8_MMA(1, 0, At, B0); PG8_BAR; PG8_SCHED;
            PG8_STAGE(PG8_SB(0, 1), b2 + hstep, voffB);
            PG8_WAIT_V(6); PG8_BAR; PG8_MMA(1, 1, At, B1); PG8_BAR;
            PG8_LDB(B0, 1, 0); PG8_SCHED; PG8_LDA(At, 1, 0); PG8_STAGE(PG8_SA(0, 1), a2 + hstep, voffA);
            PG8_WAIT_L(8); PG8_BAR; PG8_WAIT_L(0); PG8_MMA(0, 0, At, B0); PG8_BAR; PG8_SCHED;
            PG8_LDB(B1, 1, 1); PG8_STAGE(PG8_SB(1, 0), b3, voffB);
            PG8_BAR; PG8_WAIT_L(0); PG8_MMA(0, 1, At, B1); PG8_BAR;
            PG8_LDA(At, 1, 1); PG8_STAGE(PG8_SA(1, 0), a3, voffA);
            PG8_BAR; PG8_WAIT_L(0); PG8_MMA(1, 0, At, B0); PG8_BAR; PG8_SCHED;
            PG8_STAGE(PG8_SB(1, 1), b3 + hstep, voffB);
            PG8_WAIT_V(6); PG8_BAR; PG8_MMA(1, 1, At, B1); PG8_BAR;
            }
        }
        if constexpr (ALIGN_EPI) { if (wr == 0) PG8_BAR; }
        if constexpr (!Epi::AFTER_DRAIN) { E(acc, cur, wr, wc, fr, fq); S.done(cur); }
        if (!has_next) break;
#pragma unroll
        for (int a = 0; a < 2; ++a)
#pragma unroll
            for (int b = 0; b < 2; ++b)
#pragma unroll
                for (int m = 0; m < 4; ++m)
#pragma unroll
                    for (int n = 0; n < 2; ++n) acc[a][b][m][n] = (f32x4){0.f, 0.f, 0.f, 0.f};
        cur = nxt; cA = nA; cB = nB; ++ui;
        if constexpr (ALIGN_EPI) { if (wr == 1) PG8_BAR; }
    }
    PG8_WAIT_V(0);
    if constexpr (!ALIGN_EPI) { if (wr == 0) PG8_BAR; }
    PG8_BAR;
    if constexpr (Epi::AFTER_DRAIN) { E.fused(acc, cur, wr, wc, fr, fq, lds, wid, lane); S.done(cur); }
#undef PG8_SA
#undef PG8_SB
#undef PG8_STAGE
#undef PG8_LDA
#undef PG8_LDB
#undef PG8_MMA
#undef PG8_WAIT_V
#undef PG8_WAIT_L
#undef PG8_BAR
#undef PG8_SCHED
}
}
constexpr int NWAVES = 8, NT = NWAVES * 64;
constexpr int DM = 1024, M_P = 4 * 4096, M_S = 4 * 8192, M = M_P + M_S;
constexpr int NPROJ = 6688, NPAD = 6912, KOUT = 2048;
constexpr float EPS = 1e-5f;
constexpr size_t MiB = 1u << 20;
constexpr size_t WS_CTL = 0, CTL_ZERO_BYTES = 1 * MiB;
constexpr size_t CTL_SSQ_SSD = 256 * 1024, CTL_SSQ_OUT = 512 * 1024;
constexpr size_t WS_WIN = 2 * MiB;
constexpr size_t WS_WOUT = 16 * MiB;
constexpr size_t WS_ROPE = 20 * MiB;
constexpr size_t WS_DT = 22 * MiB;
constexpr size_t WS_MIX = 32 * MiB;
constexpr size_t WS_K = 224 * MiB, WS_V = 320 * MiB, WS_ZA = 416 * MiB, WS_XS = 512 * MiB;
constexpr size_t WS_BCR = 608 * MiB;
constexpr size_t WS_FREE = 656 * MiB;
constexpr size_t WS_END = 768 * MiB;
constexpr int CW_BAR = 4096;
constexpr int RING_OFF = 0, RING_BYTES = 131072;
constexpr int LDSCTL_OFF = RING_BYTES, MISC_OFF = LDSCTL_OFF + 320;
constexpr int LDS_BYTES = 147456;
#define GAS __attribute__((address_space(1)))
#define LAS __attribute__((address_space(3)))
typedef unsigned short bf16;
typedef unsigned v4u __attribute__((ext_vector_type(4)));
typedef unsigned v2u __attribute__((ext_vector_type(2)));
typedef float f32x4 __attribute__((ext_vector_type(4)));
#define LDS_WAIT() asm volatile("s_waitcnt lgkmcnt(0)" ::: "memory")
#define VM_WAIT() asm volatile("s_waitcnt vmcnt(0)" ::: "memory")
__device__ __forceinline__ unsigned f2bf(float f) { unsigned u = __builtin_bit_cast(unsigned, f); return (u + 0x7fffu + ((u >> 16) & 1u)) >> 16; }
__device__ __forceinline__ unsigned pk2(float lo, float hi) { return f2bf(lo) | (f2bf(hi) << 16); }
__device__ __forceinline__ float bf2f(unsigned short b) { return __builtin_bit_cast(float, (unsigned)b << 16); }
__device__ __forceinline__ float bflo(unsigned w) { return __builtin_bit_cast(float, w << 16); }
__device__ __forceinline__ float bfhi(unsigned w) { return __builtin_bit_cast(float, w & 0xffff0000u); }
__device__ __forceinline__ float silu_f(float v) { return v / (1.f + __expf(-v)); }
#define XB_TMO      128
#define XB_XCNT(j)  (256  + 64 * (j))
#define XB_XSUB(j)  (1280 + 64 * (j))
#define XB_XGEN(j)  (2304 + 64 * (j))
#define XB_TOP      3328
#define XB_TOPGEN   3392
#define XCD_BAR_WORDS 3456
#define XB_SPIN_CAP (1u << 18)

__device__ __forceinline__ unsigned xb_ld(unsigned* p)              { return __hip_atomic_load(p, __ATOMIC_RELAXED, __HIP_MEMORY_SCOPE_AGENT); }
__device__ __forceinline__ unsigned xb_add(unsigned* p, unsigned v) { return __hip_atomic_fetch_add(p, v, __ATOMIC_RELAXED, __HIP_MEMORY_SCOPE_AGENT); }
__device__ __forceinline__ unsigned xb_xcc_id() { return (unsigned)__builtin_amdgcn_s_getreg((3 << 11) | 20) & 0xFu; }
#define XB_SPIN(cond, bar) do { unsigned _sp = 0; while (cond) { __builtin_amdgcn_s_sleep(1); \
    if ((++_sp & 255u) == 0u) { if (xb_ld(&(bar)[XB_TMO])) break; if (_sp > XB_SPIN_CAP) { atomicAdd(&(bar)[XB_TMO], 1u); break; } } } } while (0)

struct XcdBarrier {
    unsigned* bar; unsigned x;
    volatile LAS unsigned* st;
};

__device__ __forceinline__ XcdBarrier xcd_barrier_post(unsigned* bar, volatile LAS unsigned* st) {
    XcdBarrier b; b.bar = bar; b.x = xb_xcc_id(); b.st = st;
    if (threadIdx.x == 0) (void)xb_add(&bar[XB_XCNT(b.x)], 1u);
    return b;
}
__device__ __forceinline__ void xcd_barrier_complete(unsigned* bar, unsigned x, unsigned& nloc, unsigned& nx) {
    const unsigned G = gridDim.x * gridDim.y * gridDim.z;
    unsigned sum, cnt, mine, sp = 0u;
    for (;;) {
        sum = 0u; cnt = 0u; mine = 0u;
#pragma unroll
        for (unsigned j = 0; j < 16; ++j) { const unsigned c = xb_ld(&bar[XB_XCNT(j)]); sum += c; cnt += (c > 0u) ? 1u : 0u; mine = (j == x) ? c : mine; }
        if (sum == G) break;
        __builtin_amdgcn_s_sleep(1);
        if ((++sp & 255u) == 0u) { if (xb_ld(&bar[XB_TMO])) break; if (sp > XB_SPIN_CAP) { atomicAdd(&bar[XB_TMO], 1u); break; } }
    }
    nloc = mine > 0u ? mine : 1u; nx = cnt > 0u ? cnt : 1u;
}

__device__ __forceinline__ void xcd_barrier(const XcdBarrier& b) {
    asm volatile("s_waitcnt vmcnt(0)" ::: "memory");
    __syncthreads();
    if (threadIdx.x == 0) {
        unsigned* bar = b.bar;
        __builtin_amdgcn_s_waitcnt(0);
        unsigned nloc = b.st[0], nx = b.st[1];
        if (nloc == 0u) { xcd_barrier_complete(bar, b.x, nloc, nx); b.st[0] = nloc; b.st[1] = nx; }
        const unsigned old = xb_add(&bar[XB_XSUB(b.x)], 1u);
        const unsigned gen = old / nloc;
        if (old + 1u == (gen + 1u) * nloc) {
            __builtin_amdgcn_fence(__ATOMIC_RELEASE, "agent");
            asm volatile("s_waitcnt vmcnt(0)" ::: "memory");
            const unsigned og = xb_add(&bar[XB_TOP], 1u);
            const unsigned tg = og / nx;
            if (og + 1u == (tg + 1u) * nx) xb_add(&bar[XB_TOPGEN], 1u);
            else XB_SPIN(xb_ld(&bar[XB_TOPGEN]) == tg, bar);
            __builtin_amdgcn_fence(__ATOMIC_ACQUIRE, "agent");
            xb_add(&bar[XB_XGEN(b.x)], 1u);
            asm volatile("s_waitcnt vmcnt(0)" ::: "memory");
        } else {
            XB_SPIN(xb_ld(&bar[XB_XGEN(b.x)]) == gen, bar);
            __builtin_amdgcn_fence(__ATOMIC_ACQUIRE, "agent");
            asm volatile("s_waitcnt vmcnt(0)" ::: "memory");
        }
    }
    __syncthreads();
}
struct Args { const float* in[14]; float* out; unsigned char* ws; int ph_lo, ph_hi; };
struct Frame {
    LAS unsigned char* lds; int tid, lane, wave, G, bid;
    const float *xp, *xsm, *w_in, *conv_w, *conv_b, *dtb_f, *dtb_b, *alog_f, *alog_b, *dskip, *norm_ssd, *norm_in, *w_out, *norm_f;
    float* out; unsigned char* ws;
    bf16 *WIN, *WOUT, *MIX, *KB, *VB, *ZA, *XS, *BCR, *XN, *XC, *YF; float *ROPE, *DT, *SSQ_SSD, *SSQ_OUT;
};
__device__ __forceinline__ float wave_sum(float v) {
#pragma unroll
    for (int o = 1; o < 64; o <<= 1) v += __shfl_xor(v, o);
    return v;
}
__device__ __forceinline__ void row_info(int row, int& seq0, int& pos, int& S) {
    if (row < M_P) { S = 4096; pos = row & 4095; seq0 = row & ~4095; } else { const int r = row - M_P; S = 8192; pos = r & 8191; seq0 = M_P + (r & ~8191); }
}
__device__ __forceinline__ int win_dst_row(int s) { if (s < 2048) { const int d = s & 63; return (s & ~63) + (d < 32 ? 2 * d : 2 * (d - 32) + 1); } return s; }
template <bool PERMQ>
__device__ __forceinline__ void transpose_item(const float* W, int K, int N, bf16* WT, const float* kscale, int nscale, LAS float* scr, int item, int lane) {
    const int nblk = N / 32, kb = item / nblk, nb = item % nblk, k0 = 64 * kb, n0 = 32 * nb;
#pragma unroll 8
    for (int i = 0; i < 32; ++i) { const int kk = 2 * i + (lane >> 5); const float sc = (k0 + kk < nscale) ? kscale[k0 + kk] : 1.f;
        scr[kk * 33 + (lane & 31)] = W[(size_t)(k0 + kk) * N + n0 + (lane & 31)] * sc; }
    LDS_WAIT(); asm volatile("" ::: "memory");
    const int c = lane & 7;
#pragma unroll
    for (int j = 0; j < 4; ++j) { const int n = (lane >> 3) + 8 * j; const LAS float* s = scr + (8 * c) * 33 + n;
        v4u o; o.x = pk2(s[0 * 33], s[1 * 33]); o.y = pk2(s[2 * 33], s[3 * 33]); o.z = pk2(s[4 * 33], s[5 * 33]); o.w = pk2(s[6 * 33], s[7 * 33]);
        const int dst = PERMQ ? win_dst_row(n0 + n) : (n0 + n);
        *(GAS v4u*)(WT + (size_t)dst * K + k0 + 8 * c) = o; }
    LDS_WAIT(); asm volatile("" ::: "memory");
}
__device__ __forceinline__ void p0_prologue(Frame& F) {
    LAS float* scr = (LAS float*)(F.lds + RING_OFF + F.wave * 16384);
    const int gw = F.bid * NWAVES + F.wave, NGW = F.G * NWAVES;
    constexpr int I_IN = (DM / 64) * (NPROJ / 32), I_OUT = (KOUT / 64) * (DM / 32);
    for (int it = gw; it < I_IN + I_OUT; it += NGW) {
        if (it < I_IN) transpose_item<true>(F.w_in, DM, NPROJ, F.WIN, F.norm_in, DM, scr, it, F.lane);
        else transpose_item<false>(F.w_out, KOUT, DM, F.WOUT, F.norm_ssd, 1024, scr, it - I_IN, F.lane);
    }
    {
        const int gt = F.bid * NT + F.tid, NGT = F.G * NT; constexpr int NV = (NPAD - NPROJ) * DM / 8;
        GAS v4u* z = (GAS v4u*)(F.WIN + (size_t)NPROJ * DM);
        for (int i = gt; i < NV; i += NGT) z[i] = (v4u){0u, 0u, 0u, 0u};
        for (int i = gt; i < 8192 * 32; i += NGT) {
            const int pos = i >> 5, j = i & 31; double inv = 1.0; for (int q = 0; q < j; ++q) inv *= 0.7498942093324558273;
            const double ang = (double)pos * inv; const double k = rint(ang * 0.15915494309189533577); double r = ang - k * 6.283185307179586476925;
            const double qd = rint(r * 0.63661977236758134308); const double t = r - qd * 1.57079632679489661923; const double t2 = t * t;
            double sn = t * (1.0 + t2 * (-1.0 / 6 + t2 * (1.0 / 120 + t2 * (-1.0 / 5040 + t2 * (1.0 / 362880 + t2 * (-1.0 / 39916800 + t2 * (1.0 / 6227020800.0)))))));
            double cs = 1.0 + t2 * (-0.5 + t2 * (1.0 / 24 + t2 * (-1.0 / 720 + t2 * (1.0 / 40320 + t2 * (-1.0 / 3628800 + t2 * (1.0 / 479001600.0 + t2 * (-1.0 / 87178291200.0)))))));
            const int qi = ((int)qd) & 3; double c, s;
            if (qi == 0) { c = cs; s = sn; } else if (qi == 1) { c = -sn; s = cs; } else if (qi == 2) { c = -cs; s = -sn; } else { c = sn; s = -cs; }
            F.ROPE[2 * i] = (float)c; F.ROPE[2 * i + 1] = (float)s;
        }
    }
    for (int m = gw; m < M; m += NGW) {
        const float* xrow = m < M_P ? F.xp + (size_t)m * DM : F.xsm + (size_t)(m - M_P) * DM;
        const GAS f32x4* xr = (const GAS f32x4*)xrow + F.lane; f32x4 v[4]; float s = 0.f;
#pragma unroll
        for (int j = 0; j < 4; ++j) { v[j] = xr[64 * j]; s += (v[j].x * v[j].x + v[j].y * v[j].y) + (v[j].z * v[j].z + v[j].w * v[j].w); }
        const float rs = 1.f / sqrtf(wave_sum(s) * (1.f / DM) + EPS);
        GAS unsigned long long* o8 = (GAS unsigned long long*)(F.XN + (size_t)m * DM) + F.lane;
#pragma unroll
        for (int j = 0; j < 4; ++j) o8[64 * j] = (unsigned long long)pk2(v[j].x * rs, v[j].y * rs) | ((unsigned long long)pk2(v[j].z * rs, v[j].w * rs) << 32);
    }
}
__device__ __forceinline__ void nv_conv(Frame& F) {
    const int gt = F.bid * NT + F.tid, NGT = F.G * NT;
    for (int i = gt; i < M * 192; i += NGT) {
        const int row = i / 192, c8 = (i % 192) * 8; int seq0, pos, S; row_info(row, seq0, pos, S);
        float a[8];
#pragma unroll
        for (int e = 0; e < 8; ++e) a[e] = F.conv_b[c8 + e];
#pragma unroll
        for (int j = 0; j < 5; ++j) { const int p2 = pos + j - 2; if (p2 < 0 || p2 >= S) continue; const int r2 = seq0 + p2;
            const v4u w = c8 < 1024 ? *(const v4u*)(F.XS + (size_t)r2 * 1024 + c8) : *(const v4u*)(F.BCR + (size_t)r2 * 512 + (c8 - 1024));
            const float* cw = F.conv_w + j * 1536 + c8;
            a[0] += cw[0] * bflo(w.x); a[1] += cw[1] * bfhi(w.x); a[2] += cw[2] * bflo(w.y); a[3] += cw[3] * bfhi(w.y);
            a[4] += cw[4] * bflo(w.z); a[5] += cw[5] * bfhi(w.z); a[6] += cw[6] * bflo(w.w); a[7] += cw[7] * bfhi(w.w); }
#pragma unroll
        for (int e = 0; e < 8; ++e) a[e] = silu_f(a[e]);
        v4u o; o.x = pk2(a[0], a[1]); o.y = pk2(a[2], a[3]); o.z = pk2(a[4], a[5]); o.w = pk2(a[6], a[7]);
        *(v4u*)(F.XC + (size_t)row * 1536 + c8) = o;
    }
}
__device__ __forceinline__ void nv_ssd_chain(Frame& F, int item, int dir) {
    const int b = item >> 4, head = item & 15, g = head >> 3;
    const int S = b < 4 ? 4096 : 8192, seq0 = b < 4 ? b * 4096 : M_P + (b - 4) * 8192;
    LAS float* Bs = (LAS float*)(F.lds); LAS float* Cs = Bs + 32 * 128; LAS float* xs = Cs + 32 * 128; LAS float* dtv = xs + 32 * 64; LAS float* dAv = dtv + 32; LAS float* yp = dAv + 32;
    const int p = F.tid & 63, ng = F.wave;
    const float A = -__expf(dir ? F.alog_b[head] : F.alog_f[head]); const float dtb = dir ? F.dtb_b[head] : F.dtb_f[head]; const float Dh = F.dskip[head];
    float St[16];
#pragma unroll
    for (int j = 0; j < 16; ++j) St[j] = 0.f;
    for (int blk = 0; blk < S / 32; ++blk) {
        __syncthreads();
        for (int e = F.tid; e < 32 * 128; e += NT) { const int i = e >> 7, n = e & 127; const int t = dir ? S - 1 - (blk * 32 + i) : blk * 32 + i;
            const bf16* r = F.XC + (size_t)(seq0 + t) * 1536; Bs[e] = bf2f(r[1024 + g * 128 + n]); Cs[e] = bf2f(r[1280 + g * 128 + n]); }
        for (int e = F.tid; e < 32 * 64; e += NT) { const int i = e >> 6, pp = e & 63; const int t = dir ? S - 1 - (blk * 32 + i) : blk * 32 + i;
            xs[e] = bf2f(F.XC[(size_t)(seq0 + t) * 1536 + head * 64 + pp]); }
        if (F.tid < 32) { const int t = dir ? S - 1 - (blk * 32 + F.tid) : blk * 32 + F.tid; const float raw = F.DT[(size_t)(seq0 + t) * 32 + dir * 16 + head] + dtb;
            const float dt = raw > 20.f ? raw : log1pf(__expf(raw)); dtv[F.tid] = dt; dAv[F.tid] = __expf(dt * A); }
        __syncthreads();
        for (int i = 0; i < 32; ++i) {
            const float xdt = xs[i * 64 + p] * dtv[i], da = dAv[i]; float y = 0.f;
#pragma unroll
            for (int j = 0; j < 16; ++j) { const int n = ng * 16 + j; St[j] = St[j] * da + xdt * Bs[i * 128 + n]; y += Cs[i * 128 + n] * St[j]; }
            yp[(i * 8 + ng) * 64 + p] = y;
        }
        __syncthreads();
        for (int e = F.tid; e < 2048; e += NT) { const int i = e >> 6, pp = e & 63; float y = 0.f;
#pragma unroll
            for (int q = 0; q < 8; ++q) y += yp[(i * 8 + q) * 64 + pp];
            const int t = dir ? S - 1 - (blk * 32 + i) : blk * 32 + i; const size_t row = (size_t)(seq0 + t);
            if (dir == 0) F.YF[row * 1024 + head * 64 + pp] = (bf16)f2bf(y);
            else { const float tot = y + bf2f(F.YF[row * 1024 + head * 64 + pp]) + Dh * xs[i * 64 + pp];
                bf16* zp = F.MIX + row * 2048 + head * 64 + pp; const float val = tot * silu_f(bf2f(*zp)); *zp = (bf16)f2bf(val);
                const float sq = wave_sum(val * val); if (F.lane == 0) atomicAdd(F.SSQ_SSD + row, sq); }
        }
    }
}
__device__ __forceinline__ void nv_attn_unit(Frame& F, int unit) {
    const int idx = unit * NT + F.tid; const int head = idx / M, row = idx % M; int seq0, pos, S; row_info(row, seq0, pos, S);
    float q[64], o[64];
    { const v4u* qp = (const v4u*)(F.MIX + (size_t)row * 2048 + 1024 + head * 64);
#pragma unroll
      for (int c = 0; c < 8; ++c) { const v4u w = qp[c]; q[8 * c] = bflo(w.x); q[8 * c + 1] = bfhi(w.x); q[8 * c + 2] = bflo(w.y); q[8 * c + 3] = bfhi(w.y); q[8 * c + 4] = bflo(w.z); q[8 * c + 5] = bfhi(w.z); q[8 * c + 6] = bflo(w.w); q[8 * c + 7] = bfhi(w.w); } }
#pragma unroll
    for (int d = 0; d < 64; ++d) o[d] = 0.f;
    float mx = -INFINITY, l = 0.f;
    for (int pat = 0; pat < 3; ++pat) { const int dil = pat == 0 ? 1 : (pat == 1 ? 4 : 16);
        for (int mm = -64; mm <= 64; ++mm) { const int p2 = pos + mm * dil; if (p2 < 0 || p2 >= S) continue; const size_t r2 = (size_t)(seq0 + p2);
            const v4u* kp = (const v4u*)(F.KB + r2 * 1024 + head * 64); float s = 0.f;
#pragma unroll
            for (int c = 0; c < 8; ++c) { const v4u w = kp[c]; s += q[8 * c] * bflo(w.x) + q[8 * c + 1] * bfhi(w.x) + q[8 * c + 2] * bflo(w.y) + q[8 * c + 3] * bfhi(w.y) + q[8 * c + 4] * bflo(w.z) + q[8 * c + 5] * bfhi(w.z) + q[8 * c + 6] * bflo(w.w) + q[8 * c + 7] * bfhi(w.w); }
            if (s > mx) { const float f = exp2f(mx - s); l *= f;
#pragma unroll
                for (int d = 0; d < 64; ++d) o[d] *= f;
                mx = s; }
            const float pw = exp2f(s - mx); l += pw;
            const v4u* vp = (const v4u*)(F.VB + r2 * 1024 + head * 64);
#pragma unroll
            for (int c = 0; c < 8; ++c) { const v4u w = vp[c]; o[8 * c] += pw * bflo(w.x); o[8 * c + 1] += pw * bfhi(w.x); o[8 * c + 2] += pw * bflo(w.y); o[8 * c + 3] += pw * bfhi(w.y); o[8 * c + 4] += pw * bflo(w.z); o[8 * c + 5] += pw * bfhi(w.z); o[8 * c + 6] += pw * bflo(w.w); o[8 * c + 7] += pw * bfhi(w.w); }
        } }
    const float il = 1.f / l; const v4u* zp = (const v4u*)(F.ZA + (size_t)row * 1024 + head * 64); v4u* op = (v4u*)(F.MIX + (size_t)row * 2048 + 1024 + head * 64);
#pragma unroll
    for (int c = 0; c < 8; ++c) { const v4u z = zp[c]; v4u w;
        w.x = pk2(o[8 * c] * il * silu_f(bflo(z.x)), o[8 * c + 1] * il * silu_f(bfhi(z.x))); w.y = pk2(o[8 * c + 2] * il * silu_f(bflo(z.y)), o[8 * c + 3] * il * silu_f(bfhi(z.y)));
        w.z = pk2(o[8 * c + 4] * il * silu_f(bflo(z.z)), o[8 * c + 5] * il * silu_f(bfhi(z.z))); w.w = pk2(o[8 * c + 6] * il * silu_f(bflo(z.w)), o[8 * c + 7] * il * silu_f(bfhi(z.w)));
        op[c] = w; }
}
__device__ __forceinline__ void nv_ssd_norm(Frame& F) {
    const int gt = F.bid * NT + F.tid, NGT = F.G * NT;
    for (int i = gt; i < M * 128; i += NGT) { const int row = i >> 7, c8 = (i & 127) * 8; const float rs = 1.f / sqrtf(F.SSQ_SSD[row] * (1.f / 1024.f) + EPS);
        v4u* p = (v4u*)(F.MIX + (size_t)row * 2048 + c8); v4u w = *p;
        w.x = pk2(bflo(w.x) * rs, bfhi(w.x) * rs); w.y = pk2(bflo(w.y) * rs, bfhi(w.y) * rs); w.z = pk2(bflo(w.z) * rs, bfhi(w.z) * rs); w.w = pk2(bflo(w.w) * rs, bfhi(w.w) * rs); *p = w; }
}
__device__ __forceinline__ void final_norm(Frame& F) {
    const int gt = F.bid * NT + F.tid, NGT = F.G * NT;
    for (int i = gt; i < M * 256; i += NGT) { const int row = i >> 8, c4 = (i & 255) * 4; const float rs = 1.f / sqrtf(F.SSQ_OUT[row] * (1.f / 1024.f) + EPS);
        f32x4* p = (f32x4*)(F.out + (size_t)row * 1024 + c4); const f32x4 g = *(const f32x4*)(F.norm_f + c4); *p = *p * rs * g; }
}
typedef short bf16x8 __attribute__((ext_vector_type(8)));
typedef short s16x4 __attribute__((ext_vector_type(4)));
typedef short v4i16_t __attribute__((ext_vector_type(4)));
typedef float f32x16 __attribute__((ext_vector_type(16)));
typedef float f32x2_t __attribute__((ext_vector_type(2))); typedef __bf16 bf16x2_t __attribute__((ext_vector_type(2)));
__device__ __forceinline__ unsigned cvtpk(float lo, float hi) { f32x2_t v = {lo, hi}; bf16x2_t b = __builtin_convertvector(v, bf16x2_t); return __builtin_bit_cast(unsigned, b); }
__device__ __forceinline__ s16x4 vtr(LAS const unsigned char* p) { return __builtin_bit_cast(s16x4, __builtin_amdgcn_ds_read_tr16_b64_v4i16((LAS v4i16_t*)p)); }
#define MFMA32(a, b, c) __builtin_amdgcn_mfma_f32_32x32x16_bf16((a), (b), (c), 0, 0, 0)
constexpr int AT_KROW = 144;
constexpr int AT_UNITS = 3072;
template <int DIL, int PASS>
__device__ __forceinline__ void attn_unit(Frame& F, int u, bf16* OST, float* LST) {
    LAS unsigned char* Ks = F.lds; LAS unsigned char* Vs = F.lds + 384 * AT_KROW;
    const int head = u & 15, tb = u >> 4;
    int S, seq0, within;
    if (tb < 64) { S = 4096; seq0 = (tb >> 4) * 4096; within = tb & 15; } else { const int t2 = tb - 64; S = 8192; seq0 = M_P + (t2 >> 5) * 8192; within = t2 & 31; }
    const int rho = within % DIL, blk = within / DIL, lsub = S / DIL, kstart = blk * 256 - 64;
    __syncthreads();
    for (int e = F.tid; e < 3072; e += NT) { const int i = e >> 3, c = e & 7, ku = kstart + i; v4u kv = {0u, 0u, 0u, 0u}, vv = {0u, 0u, 0u, 0u};
        if (ku >= 0 && ku < lsub) { const size_t off = (size_t)(seq0 + ku * DIL + rho) * 1024 + head * 64 + c * 8; kv = *(const v4u*)(F.KB + off); vv = *(const v4u*)(F.VB + off); }
        *(LAS v4u*)(Ks + i * AT_KROW + c * 16) = kv; *(LAS v4u*)(Vs + i * AT_KROW + c * 16) = vv; }
    __syncthreads();
    const int w = F.wave, lane = F.lane, c = lane & 31, h = lane >> 5;
    const size_t rowq = (size_t)(seq0 + (blk * 256 + 32 * w + c) * DIL + rho);
    bf16x8 qf[4];
#pragma unroll
    for (int s = 0; s < 4; ++s) qf[s] = *(const bf16x8*)(F.MIX + rowq * 2048 + 1024 + head * 64 + 16 * s + 8 * h);
    f32x16 sc[5];
#pragma unroll
    for (int kbl = 0; kbl < 5; ++kbl) {
        f32x16 a;
#pragma unroll
        for (int i = 0; i < 16; ++i) a[i] = 0.f;
        LAS const unsigned char* kp = Ks + (32 * (w + kbl) + c) * AT_KROW + 16 * h;
#pragma unroll
        for (int s = 0; s < 4; ++s) { const bf16x8 kf = *(LAS const bf16x8*)(kp + 32 * s); a = MFMA32(kf, qf[s], a); }
        sc[kbl] = a;
    }
#pragma unroll
    for (int i = 0; i < 16; ++i) { const int ri = (i & 3) + 8 * (i >> 2) + 4 * h;
        sc[0][i] = ri >= c ? sc[0][i] : -INFINITY; sc[4][i] = ri <= c ? sc[4][i] : -INFINITY; }
    if (blk == 0 || (blk + 1) * 256 == lsub) {
#pragma unroll
        for (int kbl = 0; kbl < 5; ++kbl)
#pragma unroll
            for (int i = 0; i < 16; ++i) { const int ku = kstart + 32 * (w + kbl) + (i & 3) + 8 * (i >> 2) + 4 * h; sc[kbl][i] = (ku >= 0 && ku < lsub) ? sc[kbl][i] : -INFINITY; }
    }
    float mx = -INFINITY;
#pragma unroll
    for (int kbl = 0; kbl < 5; ++kbl)
#pragma unroll
        for (int i = 0; i < 16; ++i) mx = fmaxf(mx, sc[kbl][i]);
    mx = fmaxf(mx, __shfl_xor(mx, 32));
    float l = 0.f;
#pragma unroll
    for (int kbl = 0; kbl < 5; ++kbl)
#pragma unroll
        for (int i = 0; i < 16; ++i) { const float p = exp2f(sc[kbl][i] - mx); sc[kbl][i] = p; l += p; }
    l += __shfl_xor(l, 32);
    f32x16 o[2];
#pragma unroll
    for (int i = 0; i < 16; ++i) { o[0][i] = 0.f; o[1][i] = 0.f; }
    LAS const unsigned char* vb = Vs + (4 * h + ((lane & 15) >> 2)) * AT_KROW + (16 * ((lane >> 4) & 1) + 4 * (lane & 3)) * 2;
#pragma unroll
    for (int kbl = 0; kbl < 5; ++kbl)
#pragma unroll
        for (int s2 = 0; s2 < 2; ++s2) {
            v4u pw; pw.x = cvtpk(sc[kbl][8 * s2], sc[kbl][8 * s2 + 1]); pw.y = cvtpk(sc[kbl][8 * s2 + 2], sc[kbl][8 * s2 + 3]);
            pw.z = cvtpk(sc[kbl][8 * s2 + 4], sc[kbl][8 * s2 + 5]); pw.w = cvtpk(sc[kbl][8 * s2 + 6], sc[kbl][8 * s2 + 7]);
            const bf16x8 pf = __builtin_bit_cast(bf16x8, pw);
            LAS const unsigned char* vk = vb + (32 * (w + kbl) + 16 * s2) * AT_KROW;
#pragma unroll
            for (int dt = 0; dt < 2; ++dt) {
                const s16x4 lo = vtr(vk + dt * 64), hi = vtr(vk + 8 * AT_KROW + dt * 64);
                const bf16x8 vf = __builtin_shufflevector(lo, hi, 0, 1, 2, 3, 4, 5, 6, 7);
                o[dt] = MFMA32(vf, pf, o[dt]);
            }
        }
    const float il = 1.f / l; float lse = mx + log2f(l);
#pragma unroll
    for (int i = 0; i < 16; ++i) { o[0][i] *= il; o[1][i] *= il; }
    bf16* st = OST + rowq * 1024 + head * 64 + 4 * h;
    if (PASS != 0) {
        const float lse0 = LST[rowq * 16 + head]; const float ln = fmaxf(lse, lse0) + log2f(1.f + exp2f(-fabsf(lse - lse0)));
        const float wa = exp2f(lse0 - ln), wb = exp2f(lse - ln);
#pragma unroll
        for (int dt = 0; dt < 2; ++dt)
#pragma unroll
            for (int g = 0; g < 4; ++g) { const v2u pv = *(const v2u*)(st + dt * 32 + 8 * g);
                o[dt][4 * g] = o[dt][4 * g] * wb + bflo(pv.x) * wa; o[dt][4 * g + 1] = o[dt][4 * g + 1] * wb + bfhi(pv.x) * wa;
                o[dt][4 * g + 2] = o[dt][4 * g + 2] * wb + bflo(pv.y) * wa; o[dt][4 * g + 3] = o[dt][4 * g + 3] * wb + bfhi(pv.y) * wa; }
        lse = ln;
    }
    if (PASS != 2) {
#pragma unroll
        for (int dt = 0; dt < 2; ++dt)
#pragma unroll
            for (int g = 0; g < 4; ++g) { v2u pv; pv.x = cvtpk(o[dt][4 * g], o[dt][4 * g + 1]); pv.y = cvtpk(o[dt][4 * g + 2], o[dt][4 * g + 3]); *(v2u*)(st + dt * 32 + 8 * g) = pv; }
        if (h == 0) LST[rowq * 16 + head] = lse;
    } else {
        const bf16* zp = F.ZA + rowq * 1024 + head * 64 + 4 * h; bf16* yp = F.MIX + rowq * 2048 + 1024 + head * 64 + 4 * h;
#pragma unroll
        for (int dt = 0; dt < 2; ++dt)
#pragma unroll
            for (int g = 0; g < 4; ++g) { const v2u z = *(const v2u*)(zp + dt * 32 + 8 * g); v2u pv;
                pv.x = cvtpk(o[dt][4 * g] * silu_f(bflo(z.x)), o[dt][4 * g + 1] * silu_f(bfhi(z.x))); pv.y = cvtpk(o[dt][4 * g + 2] * silu_f(bflo(z.y)), o[dt][4 * g + 3] * silu_f(bfhi(z.y)));
                *(v2u*)(yp + dt * 32 + 8 * g) = pv; }
    }
}
#ifndef MK_ONE_LAUNCH
#define MK_ONE_LAUNCH 1
#endif
constexpr int NPHASE = 10;
__global__ void __launch_bounds__(NT, 2) hybrid_fwd(Args args) {
    extern __shared__ __attribute__((aligned(16))) unsigned char lds[];
    Frame F;
    F.lds = (LAS unsigned char*)lds; F.tid = threadIdx.x; F.lane = F.tid & 63; F.wave = __builtin_amdgcn_readfirstlane(F.tid >> 6); F.G = gridDim.x; F.bid = blockIdx.x;
    F.xp = args.in[0]; F.xsm = args.in[1]; F.w_in = args.in[2]; F.conv_w = args.in[3]; F.conv_b = args.in[4]; F.dtb_f = args.in[5]; F.dtb_b = args.in[6];
    F.alog_f = args.in[7]; F.alog_b = args.in[8]; F.dskip = args.in[9]; F.norm_ssd = args.in[10]; F.norm_in = args.in[11]; F.w_out = args.in[12]; F.norm_f = args.in[13];
    F.out = args.out; F.ws = args.ws; unsigned char* ws = args.ws;
    F.WIN = (bf16*)(ws + WS_WIN); F.WOUT = (bf16*)(ws + WS_WOUT); F.ROPE = (float*)(ws + WS_ROPE); F.DT = (float*)(ws + WS_DT); F.MIX = (bf16*)(ws + WS_MIX);
    F.KB = (bf16*)(ws + WS_K); F.VB = (bf16*)(ws + WS_V); F.ZA = (bf16*)(ws + WS_ZA); F.XS = (bf16*)(ws + WS_XS); F.BCR = (bf16*)(ws + WS_BCR);
    F.XN = (bf16*)args.out;
    F.XC = (bf16*)args.out; F.YF = (bf16*)(ws + WS_FREE);
    F.SSQ_SSD = (float*)(ws + WS_CTL + CTL_SSQ_SSD); F.SSQ_OUT = (float*)(ws + WS_CTL + CTL_SSQ_OUT);
    for (int u = F.tid; u < (LDS_BYTES - LDSCTL_OFF) / 4; u += NT) ((LAS unsigned*)(F.lds + LDSCTL_OFF))[u] = 0u;
    __syncthreads();
    XcdBarrier bar; bar.bar = (unsigned*)(ws + WS_CTL) + CW_BAR; bar.x = 0; bar.st = nullptr;
    if (MK_ONE_LAUNCH) bar = xcd_barrier_post((unsigned*)(ws + WS_CTL) + CW_BAR, (volatile LAS unsigned*)(F.lds + MISC_OFF) + 8);
    const int lo = args.ph_lo, hi = args.ph_hi;
#define IN(k) (lo <= (k) && (k) < hi)
#define SEAM(k) do { if (IN(k) && IN((k) + 1)) xcd_barrier(bar); } while (0)
    if (IN(0)) { p0_prologue(F); SEAM(0); }
    if (IN(1)) {
        pg8::Gemm g{F.XN, F.WIN, M, NPAD, DM}; pg8::StaticOrder S; S.init(M, NPAD, F.G, F.bid);
        pg8::EpiInProj E{F.MIX, F.KB, F.VB, F.ZA, F.XS, F.BCR, F.DT, F.ROPE};
        pg8::gemm_phase<pg8::EpiInProj, pg8::StaticOrder, true, true>(F.lds + RING_OFF, g, S, E);
        SEAM(1);
    }
    bf16* OST = (bf16*)(ws + WS_FREE); float* LST = (float*)(ws + WS_FREE + 96 * MiB);
    if (IN(2)) { nv_conv(F); for (int u = F.bid; u < AT_UNITS; u += F.G) attn_unit<16, 0>(F, u, OST, LST); SEAM(2); }
    if (IN(3)) { for (int u = F.bid; u < AT_UNITS; u += F.G) attn_unit<4, 1>(F, u, OST, LST); SEAM(3); }
    if (IN(4)) { for (int u = F.bid; u < AT_UNITS; u += F.G) attn_unit<1, 2>(F, u, OST, LST); SEAM(4); }
    if (IN(5)) { if (F.bid < 128) nv_ssd_chain(F, F.bid, 0); SEAM(5); }
    if (IN(6)) { if (F.bid < 128) nv_ssd_chain(F, F.bid, 1); SEAM(6); }
    if (IN(7)) { nv_ssd_norm(F); SEAM(7); }
    if (IN(8)) {
        pg8::Gemm g{F.MIX, F.WOUT, M, DM, KOUT}; pg8::StaticOrder S; S.init(M, DM, F.G, F.bid);
        pg8::EpiOutProj E{F.xp, F.xsm, F.out, F.SSQ_OUT};
        pg8::gemm_phase<pg8::EpiOutProj, pg8::StaticOrder, true, true>(F.lds + RING_OFF, g, S, E);
        SEAM(8);
    }
    if (IN(9)) final_norm(F);
#undef IN
#undef SEAM
}
extern "C" void kernel_launch(void* const* d_in, const int* in_sizes, int n_in, void* d_out, int out_size, void* d_ws, size_t ws_size, hipStream_t stream) {
    static int grid = 0;
    if (grid == 0) {
        if (n_in != 14 || out_size != M * DM || ws_size < WS_END) { fprintf(stderr, "kernel_launch: unexpected problem: n_in %d out %d ws %zu\n", n_in, out_size, ws_size); grid = -1; return; }
        int dev = 0, cus = 0, per_cu = 0;
        if (hipGetDevice(&dev) != hipSuccess || hipDeviceGetAttribute(&cus, hipDeviceAttributeMultiprocessorCount, dev) != hipSuccess) { grid = -1; return; }
        if (hipFuncSetAttribute((const void*)hybrid_fwd, hipFuncAttributeMaxDynamicSharedMemorySize, LDS_BYTES) != hipSuccess) { fprintf(stderr, "kernel_launch: hipFuncSetAttribute failed\n"); grid = -1; return; }
        if (hipOccupancyMaxActiveBlocksPerMultiprocessor(&per_cu, (const void*)hybrid_fwd, NT, LDS_BYTES) != hipSuccess || per_cu < 1) { fprintf(stderr, "kernel_launch: occupancy query says %d\n", per_cu); per_cu = 1; }
        (void)hipGetLastError();
        grid = cus;
    }
    if (grid < 0) return;
    (void)hipMemsetAsync((char*)d_ws + WS_CTL, 0, CTL_ZERO_BYTES, stream);
    Args a{};
    for (int i = 0; i < 14; ++i) a.in[i] = (const float*)d_in[i];
    a.out = (float*)d_out; a.ws = (unsigned char*)d_ws;
#if MK_ONE_LAUNCH
    a.ph_lo = 0; a.ph_hi = NPHASE;
    hipLaunchKernelGGL(hybrid_fwd, dim3(grid), dim3(NT), LDS_BYTES, stream, a);
#else
    for (int p = 0; p < NPHASE; ++p) { a.ph_lo = p; a.ph_hi = p + 1; hipLaunchKernelGGL(hybrid_fwd, dim3(grid), dim3(NT), LDS_BYTES, stream, a); }
#endif
}
```

```cpp
#include <hip/hip_runtime.h>
#include <cstdio>
#include <cstdint>
#include <cmath>
namespace pg8 {
#define PG8_LAS __attribute__((address_space(3)))
typedef unsigned short bf16_t;
typedef short bf16x8 __attribute__((ext_vector_type(8)));
typedef float f32x4 __attribute__((ext_vector_type(4)));
typedef unsigned u32x4 __attribute__((ext_vector_type(4)));
constexpr int BM = 256, BK = 64, HALF = 128, HTB = HALF * BK * 2  , STAGE_BYTES = 8 * HTB, NXCD = 8, WGM = 8;

__host__ __device__ __forceinline__ int lds_byte(int r, int c) { const int st = (r >> 4) * 2 + (c >> 5), rr = r & 15, cc = c & 31, ob = rr * 64 + cc * 2; return st * 1024 + (ob ^ (((ob >> 9) & 1) << 5)); }
__host__ __device__ __forceinline__ void stage_rc(int b, int& R, int& C) { const int st = b / 1024, sb = b % 1024, swz = sb ^ (((sb >> 9) & 1) << 5); R = (st >> 1) * 16 + swz / 64; C = (st & 1) * 32 + (swz % 64) / 2; }
__host__ __device__ __forceinline__ int perm32(int rho) { const int n = rho >> 4, i = rho & 15; return 8 * (i >> 2) + 4 * n + (i & 3); }

struct Unit { int pm, pn; };
struct Gemm { const bf16_t* A; const bf16_t* Bt; int M, N, K; };

struct StaticOrder {
    int nM, nN, nwg, G, c;
    __host__ __device__ void init(int M, int N, int G_, int c_) { nM = M / BM; nN = N / BM; nwg = nM * nN; G = G_; c = c_; }
    __host__ __device__ bool next(int i, Unit& u) const {
        const long L = (long)i * G + c; if (L >= nwg) return false;
        int wgid = (int)L; { const int q = nwg / NXCD, r = nwg % NXCD, xcd = wgid % NXCD, off = wgid / NXCD; wgid = (xcd < r ? xcd * (q + 1) : r * (q + 1) + (xcd - r) * q) + off; }
        const int nig = WGM * nN, gid = wgid / nig, fm = gid * WGM, gsz = (nM - fm) < WGM ? (nM - fm) : WGM;
        u.pm = fm + ((wgid % nig) % gsz); u.pn = (wgid % nig) / gsz; return true;
    }
    __device__ __forceinline__ void a_ready(const Unit&) const {}
    __device__ __forceinline__ void done(const Unit&) const {}
};

__device__ __forceinline__ unsigned cvt_pk_bf16(float lo, float hi) { unsigned r; asm volatile("v_cvt_pk_bf16_f32 %0, %1, %2" : "=v"(r) : "v"(lo), "v"(hi)); return r; }
typedef float f32x2 __attribute__((ext_vector_type(2)));
__device__ __forceinline__ f32x2 gelu_pk(f32x2 v) {
    const f32x2 av = __builtin_elementwise_abs(v), d = av * 0.2316418882f + 1.0f;
    f32x2 t; t.x = __builtin_amdgcn_rcpf(d.x); t.y = __builtin_amdgcn_rcpf(d.y);
    f32x2 q = t * 0.5307027145f + (-0.7265760135f); q = q * t + 0.7107068705f; q = q * t + (-0.142248368f); q = q * t + 0.127414796f; q = q * t;
    const f32x2 s = (v * v) * (-0.72134752044f);
    f32x2 e; e.x = __builtin_amdgcn_exp2f(s.x); e.y = __builtin_amdgcn_exp2f(s.y);
    const f32x2 m = v * (q * e), r = v - m;
    f32x2 o; o.x = v.x < 0.f ? m.x : r.x; o.y = v.y < 0.f ? m.y : r.y; return o;
}

struct EpiInProj {
    static constexpr bool PERM = true, AFTER_DRAIN = false;
    bf16_t *MIX, *KB, *VB, *ZA, *XS, *BCR; float* DT; const float* rope;
    __device__ __forceinline__ void operator()(const f32x4 (&acc)[2][2][4][2], const Unit& u, int wr, int wc, int fr, int fq) const {
        const int row0 = u.pm * BM + wr * 64 + fr; const int pn = u.pn;
        if (pn == 26) {
            if (wc == 0) {
#pragma unroll
                for (int ai = 0; ai < 2; ++ai)
#pragma unroll
                    for (int m = 0; m < 4; ++m) { float* rp = DT + (size_t)(row0 + ai * HALF + m * 16) * 32 + 8 * fq;
                        *(f32x4*)rp = acc[ai][0][m][0]; *(f32x4*)(rp + 4) = acc[ai][0][m][1]; }
            }
            return;
        }
        bf16_t* base; int ldc, colt, mode = 0;
        if (pn < 4)       { base = MIX + 1024; ldc = 2048; colt = pn * 256; mode = 1; }
        else if (pn < 8)  { base = KB;  ldc = 1024; colt = (pn - 4) * 256; mode = 2; }
        else if (pn < 12) { base = VB;  ldc = 1024; colt = (pn - 8) * 256; }
        else if (pn < 16) { base = ZA;  ldc = 1024; colt = (pn - 12) * 256; }
        else if (pn < 20) { base = MIX; ldc = 2048; colt = (pn - 16) * 256; }
        else if (pn < 24) { base = XS;  ldc = 1024; colt = (pn - 20) * 256; }
        else              { base = BCR; ldc = 512;  colt = (pn - 24) * 256; }
        const int col0 = colt + wc * 32 + 8 * fq;
        const float qs = (mode == 1) ? 0.125f * 1.4426950408889634f : 1.0f;
        const int j0 = (wc & 1) * 16 + 4 * fq;
#pragma unroll
        for (int ai = 0; ai < 2; ++ai)
#pragma unroll
            for (int m = 0; m < 4; ++m) {
                const int row = row0 + ai * HALF + m * 16;
                bf16_t* rowp = base + (size_t)row * ldc + col0;
                f32x4 cs0 = {1.f, 0.f, 1.f, 0.f}, cs1 = {1.f, 0.f, 1.f, 0.f};
                if (mode != 0) { const int pos = row < 16384 ? (row & 4095) : ((row - 16384) & 8191);
                    const float* rp = rope + ((size_t)pos * 32 + j0) * 2; cs0 = *(const f32x4*)rp; cs1 = *(const f32x4*)(rp + 4); }
#pragma unroll
                for (int bj = 0; bj < 2; ++bj) {
                    f32x4 v0 = acc[ai][bj][m][0], v1 = acc[ai][bj][m][1];
                    if (mode != 0) {
                        f32x4 a, b;
                        a[0] = v0[0] * cs0[0] - v0[1] * cs0[1]; a[1] = v0[1] * cs0[0] + v0[0] * cs0[1];
                        a[2] = v0[2] * cs0[2] - v0[3] * cs0[3]; a[3] = v0[3] * cs0[2] + v0[2] * cs0[3];
                        b[0] = v1[0] * cs1[0] - v1[1] * cs1[1]; b[1] = v1[1] * cs1[0] + v1[0] * cs1[1];
                        b[2] = v1[2] * cs1[2] - v1[3] * cs1[3]; b[3] = v1[3] * cs1[2] + v1[2] * cs1[3];
                        v0 = a * qs; v1 = b * qs;
                    }
                    u32x4 w; w.x = cvt_pk_bf16(v0[0], v0[1]); w.y = cvt_pk_bf16(v0[2], v0[3]); w.z = cvt_pk_bf16(v1[0], v1[1]); w.w = cvt_pk_bf16(v1[2], v1[3]);
                    *(u32x4*)(rowp + bj * HALF) = w;
                }
            }
    }
};
struct EpiOutProj {
    static constexpr bool PERM = false, AFTER_DRAIN = false;
    const float* xp; const float* xs; float* out; float* ssq;
    __device__ __forceinline__ void operator()(const f32x4 (&acc)[2][2][4][2], const Unit& u, int wr, int wc, int fr, int fq) const {
        const int row0 = u.pm * BM + wr * 64 + fr; const int col0 = u.pn * BM + wc * 32 + 4 * fq;
#pragma unroll
        for (int ai = 0; ai < 2; ++ai)
#pragma unroll
            for (int m = 0; m < 4; ++m) {
                const int row = row0 + ai * HALF + m * 16;
                const float* xr = (row < 16384 ? xp + (size_t)row * 1024 : xs + (size_t)(row - 16384) * 1024) + col0;
                float* orow = out + (size_t)row * 1024 + col0; float s = 0.f;
#pragma unroll
                for (int bj = 0; bj < 2; ++bj)
#pragma unroll
                    for (int n = 0; n < 2; ++n) { const f32x4 o = *(const f32x4*)(xr + bj * HALF + n * 16) + acc[ai][bj][m][n];
                        *(f32x4*)(orow + bj * HALF + n * 16) = o; s += (o[0] * o[0] + o[1] * o[1]) + (o[2] * o[2] + o[3] * o[3]); }
                s += __shfl_xor(s, 16); s += __shfl_xor(s, 32);
                if (fq == 0) atomicAdd(ssq + row, s);
            }
    }
};
template <class Epi, class Sched, bool ALIGN_EPI = false, bool SP2 = false>
__device__ __forceinline__ void gemm_phase(PG8_LAS unsigned char* lds, const Gemm g, const Sched& S, const Epi& E) {
    const int tid = threadIdx.x, wid = __builtin_amdgcn_readfirstlane(tid >> 6), lane = tid & 63, wr = wid >> 2, wc = wid & 3, fr = lane & 15, fq = lane >> 4;
    const int K = g.K, nt = K / BK;
    unsigned voffA[2], voffB[2];
#pragma unroll
    for (int i = 0; i < 2; ++i) { int R, C; stage_rc(tid * 16 + i * 8192, R, C); const int Rb = Epi::PERM ? ((R & ~31) + perm32(R & 31)) : R;
        voffA[i] = (unsigned)(R * K + C) * 2u; voffB[i] = (unsigned)(Rb * K + C) * 2u; }
    const size_t kstep = (size_t)(BK * 2);
    const size_t hstep = (size_t)HALF * K * 2;
    const size_t tstep = 2 * hstep;
    const unsigned ldsw = (unsigned)wid * 1024u;
    const int aoff = lds_byte(wr * 64 + fr, fq * 8), boff = lds_byte(wc * 32 + fr, fq * 8);
#define PG8_SA(b, h) (((b) * 2 + (h)) * HTB)
#define PG8_SB(b, h) ((4 + (b) * 2 + (h)) * HTB)
#define PG8_STAGE(bufoff, gbase, voff) do { _Pragma("unroll") for (int _i = 0; _i < 2; ++_i) \
        __builtin_amdgcn_global_load_lds((const unsigned*)((const char*)(gbase) + (voff)[_i]), (PG8_LAS unsigned*)(lds + (bufoff) + ldsw + _i * 8192), 16, 0, 0); } while (0)
#define PG8_LDA(dst, b, h) do { _Pragma("unroll") for (int m = 0; m < 4; ++m) _Pragma("unroll") for (int k = 0; k < 2; ++k) dst[m][k] = *(const PG8_LAS bf16x8*)(lds + PG8_SA(b, h) + aoff + m * 2048 + k * 1024); } while (0)
#define PG8_LDB(dst, b, h) do { _Pragma("unroll") for (int n = 0; n < 2; ++n) _Pragma("unroll") for (int k = 0; k < 2; ++k) dst[n][k] = *(const PG8_LAS bf16x8*)(lds + PG8_SB(b, h) + boff + n * 2048 + k * 1024); } while (0)
#define PG8_MMA(ai, bj, At, Bt) do { __builtin_amdgcn_s_setprio(1); _Pragma("unroll") for (int m = 0; m < 4; ++m) _Pragma("unroll") for (int n = 0; n < 2; ++n) _Pragma("unroll") for (int k = 0; k < 2; ++k) \
        acc[ai][bj][m][n] = __builtin_amdgcn_mfma_f32_16x16x32_bf16(Bt[n][k], At[m][k], acc[ai][bj][m][n], 0, 0, 0); __builtin_amdgcn_s_setprio(0); } while (0)
#define PG8_WAIT_V(n) asm volatile("s_waitcnt vmcnt(" #n ")" ::: "memory")
#define PG8_WAIT_L(n) asm volatile("s_waitcnt lgkmcnt(" #n ")" ::: "memory")
#define PG8_BAR __builtin_amdgcn_s_barrier()
#define PG8_SCHED __builtin_amdgcn_sched_barrier(0)
    Unit cur, nxt; int ui = 0;
    if (!S.next(0, cur)) return;
    f32x4 acc[2][2][4][2];
#pragma unroll
    for (int a = 0; a < 2; ++a)
#pragma unroll
        for (int b = 0; b < 2; ++b)
#pragma unroll
            for (int m = 0; m < 4; ++m)
#pragma unroll
                for (int n = 0; n < 2; ++n) acc[a][b][m][n] = (f32x4){0.f, 0.f, 0.f, 0.f};
    bf16x8 At[4][2], B0[2][2], B1[2][2];
    const char* cA = (const char*)g.A + (size_t)cur.pm * tstep; const char* cB = (const char*)g.Bt + (size_t)cur.pn * tstep;
    S.a_ready(cur);
    if constexpr (SP2) {
        PG8_STAGE(PG8_SB(0, 0), cB, voffB); PG8_STAGE(PG8_SB(0, 1), cB + hstep, voffB); PG8_STAGE(PG8_SA(0, 0), cA, voffA); PG8_STAGE(PG8_SA(0, 1), cA + hstep, voffA);
        if (wr == 1) PG8_BAR;
        PG8_WAIT_V(2); PG8_BAR;
        PG8_STAGE(PG8_SB(1, 0), cB + kstep, voffB); PG8_STAGE(PG8_SA(1, 0), cA + kstep, voffA); PG8_STAGE(PG8_SB(1, 1), cB + hstep + kstep, voffB);
        PG8_WAIT_V(6); PG8_BAR;
    } else {
        PG8_STAGE(PG8_SB(0, 0), cB, voffB); PG8_STAGE(PG8_SA(0, 0), cA, voffA); PG8_STAGE(PG8_SB(0, 1), cB + hstep, voffB); PG8_STAGE(PG8_SA(0, 1), cA + hstep, voffA);
        if (wr == 1) PG8_BAR;
        PG8_WAIT_V(4); PG8_BAR;
        PG8_STAGE(PG8_SB(1, 0), cB + kstep, voffB); PG8_STAGE(PG8_SA(1, 0), cA + kstep, voffA); PG8_STAGE(PG8_SB(1, 1), cB + hstep + kstep, voffB);
        PG8_WAIT_V(6); PG8_BAR;
    }
    for (;;) {
        const bool has_next = S.next(ui + 1, nxt);
        const char* nA = has_next ? (const char*)g.A + (size_t)nxt.pm * tstep : cA; const char* nB = has_next ? (const char*)g.Bt + (size_t)nxt.pn * tstep : cB;
        for (int t = 0; t < nt; t += 2) {
            const bool last = (t == nt - 2);
            const char* a1 = cA + (size_t)(t + 1) * kstep;
            const char* a2 = last ? nA : cA + (size_t)(t + 2) * kstep; const char* b2 = last ? nB : cB + (size_t)(t + 2) * kstep;
            const char* a3 = a2 + kstep; const char* b3 = b2 + kstep;
            if (last && has_next) S.a_ready(nxt);
            if constexpr (SP2) {
            PG8_LDB(B0, 0, 0); PG8_LDB(B1, 0, 1); PG8_SCHED; PG8_LDA(At, 0, 0); PG8_STAGE(PG8_SA(1, 1), a1 + hstep, voffA);
            PG8_WAIT_V(8); PG8_WAIT_L(0); PG8_BAR; PG8_MMA(0, 0, At, B0); PG8_MMA(0, 1, At, B1); PG8_BAR; PG8_SCHED;
            PG8_LDA(At, 0, 1); PG8_STAGE(PG8_SB(0, 0), b2, voffB); PG8_STAGE(PG8_SB(0, 1), b2 + hstep, voffB); PG8_STAGE(PG8_SA(0, 0), a2, voffA);
            PG8_WAIT_V(8); PG8_WAIT_L(0); PG8_BAR; PG8_MMA(1, 0, At, B0); PG8_MMA(1, 1, At, B1); PG8_BAR; PG8_SCHED;
            PG8_LDB(B0, 1, 0); PG8_LDB(B1, 1, 1); PG8_SCHED; PG8_LDA(At, 1, 0); PG8_STAGE(PG8_SA(0, 1), a2 + hstep, voffA);
            PG8_WAIT_V(8); PG8_WAIT_L(0); PG8_BAR; PG8_MMA(0, 0, At, B0); PG8_MMA(0, 1, At, B1); PG8_BAR; PG8_SCHED;
            PG8_LDA(At, 1, 1); PG8_STAGE(PG8_SB(1, 0), b3, voffB); PG8_STAGE(PG8_SB(1, 1), b3 + hstep, voffB); PG8_STAGE(PG8_SA(1, 0), a3, voffA);
            PG8_WAIT_V(8); PG8_WAIT_L(0); PG8_BAR; PG8_MMA(1, 0, At, B0); PG8_MMA(1, 1, At, B1); PG8_BAR; PG8_SCHED;
            } else {
            PG8_LDB(B0, 0, 0); PG8_SCHED; PG8_LDA(At, 0, 0); PG8_STAGE(PG8_SA(1, 1), a1 + hstep, voffA);
            PG8_WAIT_L(8); PG8_BAR; PG8_WAIT_L(0); PG8_MMA(0, 0, At, B0); PG8_BAR; PG8_SCHED;
            PG8_LDB(B1, 0, 1); PG8_STAGE(PG8_SB(0, 0), b2, voffB);
            PG8_BAR; PG8_WAIT_L(0); PG8_MMA(0, 1, At, B1); PG8_BAR;
            PG8_LDA(At, 0, 1); PG8_STAGE(PG8_SA(0, 0), a2, voffA);
            PG8_BAR; PG8_WAIT_L(0); PG8_MMA(1, 0, At, B0); PG8_BAR; PG8_SCHED;
            PG8_STAGE(PG8_SB(0, 1), b2 + hstep, voffB);
            PG8_WAIT_V(6); PG8_BAR; PG8_MMA(1, 1, At, B1); PG8_BAR;
            PG8_LDB(B0, 1, 0); PG8_SCHED; PG8_LDA(At, 1, 0); PG8_STAGE(PG8_SA(0, 1), a2 + hstep, voffA);
            PG8_WAIT_L(8); PG8_BAR; PG8_WAIT_L(0); PG8_MMA(0, 0, At, B0); PG8_BAR; PG8_SCHED;
            PG8_LDB(B1, 1, 1); PG8_STAGE(PG8_SB(1, 0), b3, voffB);
            PG8_BAR; PG8_WAIT_L(0); PG8_MMA(0, 1, At, B1); PG8_BAR;
            PG8_LDA(At, 1, 1); PG8_STAGE(PG8_SA(1, 0), a3, voffA);
            PG8_BAR; PG8_WAIT_L(0); PG8_MMA(1, 0, At, B0); PG8_BAR; PG8_SCHED;
            PG8_STAGE(PG8_SB(1, 1), b3 + hstep, voffB);
            PG8_WAIT_V(6); PG8_BAR; PG8_MMA(1, 1, At, B1); PG8_BAR;
            }
        }
        if constexpr (ALIGN_EPI) { if (wr == 0) PG8_BAR; }
        if constexpr (!Epi::AFTER_DRAIN) { E(acc, cur, wr, wc, fr, fq); S.done(cur); }
        if (!has_next) break;
#pragma unroll
        for (int a = 0; a < 2; ++a)
#pragma unroll
            for (int b = 0; b < 2; ++b)
#pragma unroll
                for (int m = 0; m < 4; ++m)
#pragma unroll
                    for (int n = 0; n < 2; ++n) acc[a][b][m][n] = (f32x4){0.f, 0.f, 0.f, 0.f};
        cur = nxt; cA = nA; cB = nB; ++ui;
        if constexpr (ALIGN_EPI) { if (wr == 1) PG8_BAR; }
    }
    PG8_WAIT_V(0);
    if constexpr (!ALIGN_EPI) { if (wr == 0) PG8_BAR; }
    PG8_BAR;
    if constexpr (Epi::AFTER_DRAIN) { E.fused(acc, cur, wr, wc, fr, fq, lds, wid, lane); S.done(cur); }
#undef PG8_SA
#undef PG8_SB
#undef PG8_STAGE
#undef PG8_LDA
#undef PG8_LDB
#undef PG8_MMA
#undef PG8_WAIT_V
#undef PG8_WAIT_L
#undef PG8_BAR
#undef PG8_SCHED
}
}
constexpr int NWAVES = 8, NT = NWAVES * 64;
constexpr int DM = 1024, M_P = 4 * 4096, M_S = 4 * 8192, M = M_P + M_S;
constexpr int NPROJ = 6688, NPAD = 6912, KOUT = 2048;
constexpr float EPS = 1e-5f;
constexpr size_t MiB = 1u << 20;
constexpr size_t WS_CTL = 0, CTL_ZERO_BYTES = 1 * MiB;
constexpr size_t CTL_SSQ_SSD = 256 * 1024, CTL_SSQ_OUT = 512 * 1024;
constexpr size_t WS_WIN = 2 * MiB;
constexpr size_t WS_WOUT = 16 * MiB;
constexpr size_t WS_ROPE = 20 * MiB;
constexpr size_t WS_DT = 22 * MiB;
constexpr size_t WS_MIX = 32 * MiB;
constexpr size_t WS_K = 224 * MiB, WS_V = 320 * MiB, WS_ZA = 416 * MiB, WS_XS = 512 * MiB;
constexpr size_t WS_BCR = 608 * MiB;
constexpr size_t WS_FREE = 656 * MiB;
constexpr size_t WS_END = 768 * MiB;
constexpr int CW_BAR = 4096, CW_QCTR = 1024;
constexpr int RING_OFF = 0, RING_BYTES = 131072;
constexpr int LDSCTL_OFF = RING_BYTES, MISC_OFF = LDSCTL_OFF + 320;
constexpr int LDS_BYTES = 147456;
#define GAS __attribute__((address_space(1)))
#define LAS __attribute__((address_space(3)))
typedef unsigned short bf16;
typedef unsigned v4u __attribute__((ext_vector_type(4)));
typedef unsigned v2u __attribute__((ext_vector_type(2)));
typedef float f32x4 __attribute__((ext_vector_type(4)));
#define LDS_WAIT() asm volatile("s_waitcnt lgkmcnt(0)" ::: "memory")
#define VM_WAIT() asm volatile("s_waitcnt vmcnt(0)" ::: "memory")
__device__ __forceinline__ unsigned f2bf(float f) { unsigned u = __builtin_bit_cast(unsigned, f); return (u + 0x7fffu + ((u >> 16) & 1u)) >> 16; }
__device__ __forceinline__ unsigned pk2(float lo, float hi) { return f2bf(lo) | (f2bf(hi) << 16); }
__device__ __forceinline__ float bf2f(unsigned short b) { return __builtin_bit_cast(float, (unsigned)b << 16); }
__device__ __forceinline__ float bflo(unsigned w) { return __builtin_bit_cast(float, w << 16); }
__device__ __forceinline__ float bfhi(unsigned w) { return __builtin_bit_cast(float, w & 0xffff0000u); }
__device__ __forceinline__ float silu_f(float v) { return v / (1.f + __expf(-v)); }
#define XB_TMO      128
#define XB_XCNT(j)  (256  + 64 * (j))
#define XB_XSUB(j)  (1280 + 64 * (j))
#define XB_XGEN(j)  (2304 + 64 * (j))
#define XB_TOP      3328
#define XB_TOPGEN   3392
#define XCD_BAR_WORDS 3456
#define XB_SPIN_CAP (1u << 18)

__device__ __forceinline__ unsigned xb_ld(unsigned* p)              { return __hip_atomic_load(p, __ATOMIC_RELAXED, __HIP_MEMORY_SCOPE_AGENT); }
__device__ __forceinline__ unsigned xb_add(unsigned* p, unsigned v) { return __hip_atomic_fetch_add(p, v, __ATOMIC_RELAXED, __HIP_MEMORY_SCOPE_AGENT); }
__device__ __forceinline__ unsigned xb_xcc_id() { return (unsigned)__builtin_amdgcn_s_getreg((3 << 11) | 20) & 0xFu; }
#define XB_SPIN(cond, bar) do { unsigned _sp = 0; while (cond) { __builtin_amdgcn_s_sleep(1); \
    if ((++_sp & 255u) == 0u) { if (xb_ld(&(bar)[XB_TMO])) break; if (_sp > XB_SPIN_CAP) { atomicAdd(&(bar)[XB_TMO], 1u); break; } } } } while (0)

struct XcdBarrier {
    unsigned* bar; unsigned x;
    volatile LAS unsigned* st;
};

__device__ __forceinline__ XcdBarrier xcd_barrier_post(unsigned* bar, volatile LAS unsigned* st) {
    XcdBarrier b; b.bar = bar; b.x = xb_xcc_id(); b.st = st;
    if (threadIdx.x == 0) (void)xb_add(&bar[XB_XCNT(b.x)], 1u);
    return b;
}
__device__ __forceinline__ void xcd_barrier_complete(unsigned* bar, unsigned x, unsigned& nloc, unsigned& nx) {
    const unsigned G = gridDim.x * gridDim.y * gridDim.z;
    unsigned sum, cnt, mine, sp = 0u;
    for (;;) {
        sum = 0u; cnt = 0u; mine = 0u;
#pragma unroll
        for (unsigned j = 0; j < 16; ++j) { const unsigned c = xb_ld(&bar[XB_XCNT(j)]); sum += c; cnt += (c > 0u) ? 1u : 0u; mine = (j == x) ? c : mine; }
        if (sum == G) break;
        __builtin_amdgcn_s_sleep(1);
        if ((++sp & 255u) == 0u) { if (xb_ld(&bar[XB_TMO])) break; if (sp > XB_SPIN_CAP) { atomicAdd(&bar[XB_TMO], 1u); break; } }
    }
    nloc = mine > 0u ? mine : 1u; nx = cnt > 0u ? cnt : 1u;
}

__device__ __forceinline__ void xcd_barrier(const XcdBarrier& b) {
    asm volatile("s_waitcnt vmcnt(0)" ::: "memory");
    __syncthreads();
    if (threadIdx.x == 0) {
        unsigned* bar = b.bar;
        __builtin_amdgcn_s_waitcnt(0);
        unsigned nloc = b.st[0], nx = b.st[1];
        if (nloc == 0u) { xcd_barrier_complete(bar, b.x, nloc, nx); b.st[0] = nloc; b.st[1] = nx; }
        const unsigned old = xb_add(&bar[XB_XSUB(b.x)], 1u);
        const unsigned gen = old / nloc;
        if (old + 1u == (gen + 1u) * nloc) {
            __builtin_amdgcn_fence(__ATOMIC_RELEASE, "agent");
            asm volatile("s_waitcnt vmcnt(0)" ::: "memory");
            const unsigned og = xb_add(&bar[XB_TOP], 1u);
            const unsigned tg = og / nx;
            if (og + 1u == (tg + 1u) * nx) xb_add(&bar[XB_TOPGEN], 1u);
            else XB_SPIN(xb_ld(&bar[XB_TOPGEN]) == tg, bar);
            __builtin_amdgcn_fence(__ATOMIC_ACQUIRE, "agent");
            xb_add(&bar[XB_XGEN(b.x)], 1u);
            asm volatile("s_waitcnt vmcnt(0)" ::: "memory");
        } else {
            XB_SPIN(xb_ld(&bar[XB_XGEN(b.x)]) == gen, bar);
            __builtin_amdgcn_fence(__ATOMIC_ACQUIRE, "agent");
            asm volatile("s_waitcnt vmcnt(0)" ::: "memory");
        }
    }
    __syncthreads();
}
struct Args { const float* in[14]; float* out; unsigned char* ws; int ph_lo, ph_hi; };
struct Frame {
    LAS unsigned char* lds; int tid, lane, wave, G, bid;
    const float *xp, *xsm, *w_in, *conv_w, *conv_b, *dtb_f, *dtb_b, *alog_f, *alog_b, *dskip, *norm_ssd, *norm_in, *w_out, *norm_f;
    float* out; unsigned char* ws;
    bf16 *WIN, *WOUT, *MIX, *KB, *VB, *ZA, *XS, *BCR, *XN, *XC, *YF; float *ROPE, *DT, *SSQ_SSD, *SSQ_OUT;
};
__device__ __forceinline__ float wave_sum(float v) {
#pragma unroll
    for (int o = 1; o < 64; o <<= 1) v += __shfl_xor(v, o);
    return v;
}
__device__ __forceinline__ void row_info(int row, int& seq0, int& pos, int& S) {
    if (row < M_P) { S = 4096; pos = row & 4095; seq0 = row & ~4095; } else { const int r = row - M_P; S = 8192; pos = r & 8191; seq0 = M_P + (r & ~8191); }
}
__device__ __forceinline__ int win_dst_row(int s) { if (s < 2048) { const int d = s & 63; return (s & ~63) + (d < 32 ? 2 * d : 2 * (d - 32) + 1); } return s; }
template <bool PERMQ>
__device__ __forceinline__ void transpose_item(const float* W, int K, int N, bf16* WT, const float* kscale, int nscale, LAS float* scr, int item, int lane) {
    const int nblk = N / 32, kb = item / nblk, nb = item % nblk, k0 = 64 * kb, n0 = 32 * nb;
#pragma unroll 8
    for (int i = 0; i < 32; ++i) { const int kk = 2 * i + (lane >> 5); const float sc = (k0 + kk < nscale) ? kscale[k0 + kk] : 1.f;
        scr[kk * 33 + (lane & 31)] = W[(size_t)(k0 + kk) * N + n0 + (lane & 31)] * sc; }
    LDS_WAIT(); asm volatile("" ::: "memory");
    const int c = lane & 7;
#pragma unroll
    for (int j = 0; j < 4; ++j) { const int n = (lane >> 3) + 8 * j; const LAS float* s = scr + (8 * c) * 33 + n;
        v4u o; o.x = pk2(s[0 * 33], s[1 * 33]); o.y = pk2(s[2 * 33], s[3 * 33]); o.z = pk2(s[4 * 33], s[5 * 33]); o.w = pk2(s[6 * 33], s[7 * 33]);
        const int dst = PERMQ ? win_dst_row(n0 + n) : (n0 + n);
        *(GAS v4u*)(WT + (size_t)dst * K + k0 + 8 * c) = o; }
    LDS_WAIT(); asm volatile("" ::: "memory");
}
__device__ __forceinline__ void p0_prologue(Frame& F) {
    LAS float* scr = (LAS float*)(F.lds + RING_OFF + F.wave * 16384);
    const int gw = F.bid * NWAVES + F.wave, NGW = F.G * NWAVES;
    constexpr int I_IN = (DM / 64) * (NPROJ / 32), I_OUT = (KOUT / 64) * (DM / 32);
    for (int it = gw; it < I_IN + I_OUT; it += NGW) {
        if (it < I_IN) transpose_item<true>(F.w_in, DM, NPROJ, F.WIN, F.norm_in, DM, scr, it, F.lane);
        else transpose_item<false>(F.w_out, KOUT, DM, F.WOUT, F.norm_ssd, 1024, scr, it - I_IN, F.lane);
    }
    {
        const int gt = F.bid * NT + F.tid, NGT = F.G * NT; constexpr int NV = (NPAD - NPROJ) * DM / 8;
        GAS v4u* z = (GAS v4u*)(F.WIN + (size_t)NPROJ * DM);
        for (int i = gt; i < NV; i += NGT) z[i] = (v4u){0u, 0u, 0u, 0u};
        for (int i = gt; i < 8192 * 32; i += NGT) {
            const int pos = i >> 5, j = i & 31; double inv = 1.0; for (int q = 0; q < j; ++q) inv *= 0.7498942093324558273;
            const double ang = (double)pos * inv; const double k = rint(ang * 0.15915494309189533577); double r = ang - k * 6.283185307179586476925;
            const double qd = rint(r * 0.63661977236758134308); const double t = r - qd * 1.57079632679489661923; const double t2 = t * t;
            double sn = t * (1.0 + t2 * (-1.0 / 6 + t2 * (1.0 / 120 + t2 * (-1.0 / 5040 + t2 * (1.0 / 362880 + t2 * (-1.0 / 39916800 + t2 * (1.0 / 6227020800.0)))))));
            double cs = 1.0 + t2 * (-0.5 + t2 * (1.0 / 24 + t2 * (-1.0 / 720 + t2 * (1.0 / 40320 + t2 * (-1.0 / 3628800 + t2 * (1.0 / 479001600.0 + t2 * (-1.0 / 87178291200.0)))))));
            const int qi = ((int)qd) & 3; double c, s;
            if (qi == 0) { c = cs; s = sn; } else if (qi == 1) { c = -sn; s = cs; } else if (qi == 2) { c = -cs; s = -sn; } else { c = sn; s = -cs; }
            F.ROPE[2 * i] = (float)c; F.ROPE[2 * i + 1] = (float)s;
        }
    }
    for (int m = gw; m < M; m += NGW) {
        const float* xrow = m < M_P ? F.xp + (size_t)m * DM : F.xsm + (size_t)(m - M_P) * DM;
        const GAS f32x4* xr = (const GAS f32x4*)xrow + F.lane; f32x4 v[4]; float s = 0.f;
#pragma unroll
        for (int j = 0; j < 4; ++j) { v[j] = xr[64 * j]; s += (v[j].x * v[j].x + v[j].y * v[j].y) + (v[j].z * v[j].z + v[j].w * v[j].w); }
        const float rs = 1.f / sqrtf(wave_sum(s) * (1.f / DM) + EPS);
        GAS unsigned long long* o8 = (GAS unsigned long long*)(F.XN + (size_t)m * DM) + F.lane;
#pragma unroll
        for (int j = 0; j < 4; ++j) o8[64 * j] = (unsigned long long)pk2(v[j].x * rs, v[j].y * rs) | ((unsigned long long)pk2(v[j].z * rs, v[j].w * rs) << 32);
    }
}
__device__ __forceinline__ void nv_conv(Frame& F) {
    const int gt = F.bid * NT + F.tid, NGT = F.G * NT;
    for (int i = gt; i < M * 192; i += NGT) {
        const int row = i / 192, c8 = (i % 192) * 8; int seq0, pos, S; row_info(row, seq0, pos, S);
        float a[8];
#pragma unroll
        for (int e = 0; e < 8; ++e) a[e] = F.conv_b[c8 + e];
#pragma unroll
        for (int j = 0; j < 5; ++j) { const int p2 = pos + j - 2; if (p2 < 0 || p2 >= S) continue; const int r2 = seq0 + p2;
            const v4u w = c8 < 1024 ? *(const v4u*)(F.XS + (size_t)r2 * 1024 + c8) : *(const v4u*)(F.BCR + (size_t)r2 * 512 + (c8 - 1024));
            const float* cw = F.conv_w + j * 1536 + c8;
            a[0] += cw[0] * bflo(w.x); a[1] += cw[1] * bfhi(w.x); a[2] += cw[2] * bflo(w.y); a[3] += cw[3] * bfhi(w.y);
            a[4] += cw[4] * bflo(w.z); a[5] += cw[5] * bfhi(w.z); a[6] += cw[6] * bflo(w.w); a[7] += cw[7] * bfhi(w.w); }
#pragma unroll
        for (int e = 0; e < 8; ++e) a[e] = silu_f(a[e]);
        v4u o; o.x = pk2(a[0], a[1]); o.y = pk2(a[2], a[3]); o.z = pk2(a[4], a[5]); o.w = pk2(a[6], a[7]);
        *(v4u*)(F.XC + (size_t)row * 1536 + c8) = o;
    }
}
__device__ __forceinline__ void nv_ssd_chain(Frame& F, int item, int dir) {
    const int b = item >> 4, head = item & 15, g = head >> 3;
    const int S = b < 4 ? 4096 : 8192, seq0 = b < 4 ? b * 4096 : M_P + (b - 4) * 8192;
    LAS float* Bs = (LAS float*)(F.lds); LAS float* Cs = Bs + 32 * 128; LAS float* xs = Cs + 32 * 128; LAS float* dtv = xs + 32 * 64; LAS float* dAv = dtv + 32; LAS float* yp = dAv + 32;
    const int p = F.tid & 63, ng = F.wave;
    const float A = -__expf(dir ? F.alog_b[head] : F.alog_f[head]); const float dtb = dir ? F.dtb_b[head] : F.dtb_f[head]; const float Dh = F.dskip[head];
    float St[16];
#pragma unroll
    for (int j = 0; j < 16; ++j) St[j] = 0.f;
    for (int blk = 0; blk < S / 32; ++blk) {
        __syncthreads();
        for (int e = F.tid; e < 32 * 128; e += NT) { const int i = e >> 7, n = e & 127; const int t = dir ? S - 1 - (blk * 32 + i) : blk * 32 + i;
            const bf16* r = F.XC + (size_t)(seq0 + t) * 1536; Bs[e] = bf2f(r[1024 + g * 128 + n]); Cs[e] = bf2f(r[1280 + g * 128 + n]); }
        for (int e = F.tid; e < 32 * 64; e += NT) { const int i = e >> 6, pp = e & 63; const int t = dir ? S - 1 - (blk * 32 + i) : blk * 32 + i;
            xs[e] = bf2f(F.XC[(size_t)(seq0 + t) * 1536 + head * 64 + pp]); }
        if (F.tid < 32) { const int t = dir ? S - 1 - (blk * 32 + F.tid) : blk * 32 + F.tid; const float raw = F.DT[(size_t)(seq0 + t) * 32 + dir * 16 + head] + dtb;
            const float dt = raw > 20.f ? raw : log1pf(__expf(raw)); dtv[F.tid] = dt; dAv[F.tid] = __expf(dt * A); }
        __syncthreads();
        for (int i = 0; i < 32; ++i) {
            const float xdt = xs[i * 64 + p] * dtv[i], da = dAv[i]; float y = 0.f;
#pragma unroll
            for (int j = 0; j < 16; ++j) { const int n = ng * 16 + j; St[j] = St[j] * da + xdt * Bs[i * 128 + n]; y += Cs[i * 128 + n] * St[j]; }
            yp[(i * 8 + ng) * 64 + p] = y;
        }
        __syncthreads();
        for (int e = F.tid; e < 2048; e += NT) { const int i = e >> 6, pp = e & 63; float y = 0.f;
#pragma unroll
            for (int q = 0; q < 8; ++q) y += yp[(i * 8 + q) * 64 + pp];
            const int t = dir ? S - 1 - (blk * 32 + i) : blk * 32 + i; const size_t row = (size_t)(seq0 + t);
            if (dir == 0) F.YF[row * 1024 + head * 64 + pp] = (bf16)f2bf(y);
            else { const float tot = y + bf2f(F.YF[row * 1024 + head * 64 + pp]) + Dh * xs[i * 64 + pp];
                bf16* zp = F.MIX + row * 2048 + head * 64 + pp; const float val = tot * silu_f(bf2f(*zp)); *zp = (bf16)f2bf(val);
                const float sq = wave_sum(val * val); if (F.lane == 0) atomicAdd(F.SSQ_SSD + row, sq); }
        }
    }
}
__device__ __forceinline__ void nv_attn_unit(Frame& F, int unit) {
    const int idx = unit * NT + F.tid; const int head = idx / M, row = idx % M; int seq0, pos, S; row_info(row, seq0, pos, S);
    float q[64], o[64];
    { const v4u* qp = (const v4u*)(F.MIX + (size_t)row * 2048 + 1024 + head * 64);
#pragma unroll
      for (int c = 0; c < 8; ++c) { const v4u w = qp[c]; q[8 * c] = bflo(w.x); q[8 * c + 1] = bfhi(w.x); q[8 * c + 2] = bflo(w.y); q[8 * c + 3] = bfhi(w.y); q[8 * c + 4] = bflo(w.z); q[8 * c + 5] = bfhi(w.z); q[8 * c + 6] = bflo(w.w); q[8 * c + 7] = bfhi(w.w); } }
#pragma unroll
    for (int d = 0; d < 64; ++d) o[d] = 0.f;
    float mx = -INFINITY, l = 0.f;
    for (int pat = 0; pat < 3; ++pat) { const int dil = pat == 0 ? 1 : (pat == 1 ? 4 : 16);
        for (int mm = -64; mm <= 64; ++mm) { const int p2 = pos + mm * dil; if (p2 < 0 || p2 >= S) continue; const size_t r2 = (size_t)(seq0 + p2);
            const v4u* kp = (const v4u*)(F.KB + r2 * 1024 + head * 64); float s = 0.f;
#pragma unroll
            for (int c = 0; c < 8; ++c) { const v4u w = kp[c]; s += q[8 * c] * bflo(w.x) + q[8 * c + 1] * bfhi(w.x) + q[8 * c + 2] * bflo(w.y) + q[8 * c + 3] * bfhi(w.y) + q[8 * c + 4] * bflo(w.z) + q[8 * c + 5] * bfhi(w.z) + q[8 * c + 6] * bflo(w.w) + q[8 * c + 7] * bfhi(w.w); }
            if (s > mx) { const float f = exp2f(mx - s); l *= f;
#pragma unroll
                for (int d = 0; d < 64; ++d) o[d] *= f;
                mx = s; }
            const float pw = exp2f(s - mx); l += pw;
            const v4u* vp = (const v4u*)(F.VB + r2 * 1024 + head * 64);
#pragma unroll
            for (int c = 0; c < 8; ++c) { const v4u w = vp[c]; o[8 * c] += pw * bflo(w.x); o[8 * c + 1] += pw * bfhi(w.x); o[8 * c + 2] += pw * bflo(w.y); o[8 * c + 3] += pw * bfhi(w.y); o[8 * c + 4] += pw * bflo(w.z); o[8 * c + 5] += pw * bfhi(w.z); o[8 * c + 6] += pw * bflo(w.w); o[8 * c + 7] += pw * bfhi(w.w); }
        } }
    const float il = 1.f / l; const v4u* zp = (const v4u*)(F.ZA + (size_t)row * 1024 + head * 64); v4u* op = (v4u*)(F.MIX + (size_t)row * 2048 + 1024 + head * 64);
#pragma unroll
    for (int c = 0; c < 8; ++c) { const v4u z = zp[c]; v4u w;
        w.x = pk2(o[8 * c] * il * silu_f(bflo(z.x)), o[8 * c + 1] * il * silu_f(bfhi(z.x))); w.y = pk2(o[8 * c + 2] * il * silu_f(bflo(z.y)), o[8 * c + 3] * il * silu_f(bfhi(z.y)));
        w.z = pk2(o[8 * c + 4] * il * silu_f(bflo(z.z)), o[8 * c + 5] * il * silu_f(bfhi(z.z))); w.w = pk2(o[8 * c + 6] * il * silu_f(bflo(z.w)), o[8 * c + 7] * il * silu_f(bfhi(z.w)));
        op[c] = w; }
}
__device__ __forceinline__ void nv_ssd_norm(Frame& F) {
    const int gt = F.bid * NT + F.tid, NGT = F.G * NT;
    for (int i = gt; i < M * 128; i += NGT) { const int row = i >> 7, c8 = (i & 127) * 8; const float rs = 1.f / sqrtf(F.SSQ_SSD[row] * (1.f / 1024.f) + EPS);
        v4u* p = (v4u*)(F.MIX + (size_t)row * 2048 + c8); v4u w = *p;
        w.x = pk2(bflo(w.x) * rs, bfhi(w.x) * rs); w.y = pk2(bflo(w.y) * rs, bfhi(w.y) * rs); w.z = pk2(bflo(w.z) * rs, bfhi(w.z) * rs); w.w = pk2(bflo(w.w) * rs, bfhi(w.w) * rs); *p = w; }
}
__device__ __forceinline__ void final_norm(Frame& F) {
    const int gt = F.bid * NT + F.tid, NGT = F.G * NT;
    for (int i = gt; i < M * 256; i += NGT) { const int row = i >> 8, c4 = (i & 255) * 4; const float rs = 1.f / sqrtf(F.SSQ_OUT[row] * (1.f / 1024.f) + EPS);
        f32x4* p = (f32x4*)(F.out + (size_t)row * 1024 + c4); const f32x4 g = *(const f32x4*)(F.norm_f + c4); *p = *p * rs * g; }
}
typedef short bf16x8 __attribute__((ext_vector_type(8)));
typedef short s16x4 __attribute__((ext_vector_type(4)));
typedef short v4i16_t __attribute__((ext_vector_type(4)));
typedef float f32x16 __attribute__((ext_vector_type(16)));
typedef float f32x2_t __attribute__((ext_vector_type(2))); typedef __bf16 bf16x2_t __attribute__((ext_vector_type(2)));
__device__ __forceinline__ unsigned cvtpk(float lo, float hi) { f32x2_t v = {lo, hi}; bf16x2_t b = __builtin_convertvector(v, bf16x2_t); return __builtin_bit_cast(unsigned, b); }
__device__ __forceinline__ s16x4 vtr(LAS const unsigned char* p) { return __builtin_bit_cast(s16x4, __builtin_amdgcn_ds_read_tr16_b64_v4i16((LAS v4i16_t*)p)); }
#define MFMA32(a, b, c) __builtin_amdgcn_mfma_f32_32x32x16_bf16((a), (b), (c), 0, 0, 0)
constexpr int AT_KROW = 144;
constexpr int AT_UNITS = 3072;
template <int DIL, int PASS>
__device__ __forceinline__ void attn_unit(Frame& F, int u, bf16* OST, float* LST) {
    LAS unsigned char* Ks = F.lds; LAS unsigned char* Vs = F.lds + 384 * AT_KROW;
    const int head = u & 15, tb = u >> 4;
    int S, seq0, within;
    if (tb < 64) { S = 4096; seq0 = (tb >> 4) * 4096; within = tb & 15; } else { const int t2 = tb - 64; S = 8192; seq0 = M_P + (t2 >> 5) * 8192; within = t2 & 31; }
    const int rho = within % DIL, blk = within / DIL, lsub = S / DIL, kstart = blk * 256 - 64;
    __syncthreads();
    for (int e = F.tid; e < 3072; e += NT) { const int i = e >> 3, c = e & 7, ku = kstart + i; v4u kv = {0u, 0u, 0u, 0u}, vv = {0u, 0u, 0u, 0u};
        if (ku >= 0 && ku < lsub) { const size_t off = (size_t)(seq0 + ku * DIL + rho) * 1024 + head * 64 + c * 8; kv = *(const v4u*)(F.KB + off); vv = *(const v4u*)(F.VB + off); }
        *(LAS v4u*)(Ks + i * AT_KROW + c * 16) = kv; *(LAS v4u*)(Vs + i * AT_KROW + c * 16) = vv; }
    __syncthreads();
    const int w = F.wave, lane = F.lane, c = lane & 31, h = lane >> 5;
    const size_t rowq = (size_t)(seq0 + (blk * 256 + 32 * w + c) * DIL + rho);
    bf16x8 qf[4];
#pragma unroll
    for (int s = 0; s < 4; ++s) qf[s] = *(const bf16x8*)(F.MIX + rowq * 2048 + 1024 + head * 64 + 16 * s + 8 * h);
    f32x16 sc[5];
#pragma unroll
    for (int kbl = 0; kbl < 5; ++kbl) {
        f32x16 a;
#pragma unroll
        for (int i = 0; i < 16; ++i) a[i] = 0.f;
        LAS const unsigned char* kp = Ks + (32 * (w + kbl) + c) * AT_KROW + 16 * h;
#pragma unroll
        for (int s = 0; s < 4; ++s) { const bf16x8 kf = *(LAS const bf16x8*)(kp + 32 * s); a = MFMA32(kf, qf[s], a); }
        sc[kbl] = a;
    }
#pragma unroll
    for (int i = 0; i < 16; ++i) { const int ri = (i & 3) + 8 * (i >> 2) + 4 * h;
        sc[0][i] = ri >= c ? sc[0][i] : -INFINITY; sc[4][i] = ri <= c ? sc[4][i] : -INFINITY; }
    if (blk == 0 || (blk + 1) * 256 == lsub) {
#pragma unroll
        for (int kbl = 0; kbl < 5; ++kbl)
#pragma unroll
            for (int i = 0; i < 16; ++i) { const int ku = kstart + 32 * (w + kbl) + (i & 3) + 8 * (i >> 2) + 4 * h; sc[kbl][i] = (ku >= 0 && ku < lsub) ? sc[kbl][i] : -INFINITY; }
    }
    float mx = -INFINITY;
#pragma unroll
    for (int kbl = 0; kbl < 5; ++kbl)
#pragma unroll
        for (int i = 0; i < 16; ++i) mx = fmaxf(mx, sc[kbl][i]);
    mx = fmaxf(mx, __shfl_xor(mx, 32));
    float l = 0.f;
#pragma unroll
    for (int kbl = 0; kbl < 5; ++kbl)
#pragma unroll
        for (int i = 0; i < 16; ++i) { const float p = exp2f(sc[kbl][i] - mx); sc[kbl][i] = p; l += p; }
    l += __shfl_xor(l, 32);
    f32x16 o[2];
#pragma unroll
    for (int i = 0; i < 16; ++i) { o[0][i] = 0.f; o[1][i] = 0.f; }
    LAS const unsigned char* vb = Vs + (4 * h + ((lane & 15) >> 2)) * AT_KROW + (16 * ((lane >> 4) & 1) + 4 * (lane & 3)) * 2;
#pragma unroll
    for (int kbl = 0; kbl < 5; ++kbl)
#pragma unroll
        for (int s2 = 0; s2 < 2; ++s2) {
            v4u pw; pw.x = cvtpk(sc[kbl][8 * s2], sc[kbl][8 * s2 + 1]); pw.y = cvtpk(sc[kbl][8 * s2 + 2], sc[kbl][8 * s2 + 3]);
            pw.z = cvtpk(sc[kbl][8 * s2 + 4], sc[kbl][8 * s2 + 5]); pw.w = cvtpk(sc[kbl][8 * s2 + 6], sc[kbl][8 * s2 + 7]);
            const bf16x8 pf = __builtin_bit_cast(bf16x8, pw);
            LAS const unsigned char* vk = vb + (32 * (w + kbl) + 16 * s2) * AT_KROW;
#pragma unroll
            for (int dt = 0; dt < 2; ++dt) {
                const s16x4 lo = vtr(vk + dt * 64), hi = vtr(vk + 8 * AT_KROW + dt * 64);
                const bf16x8 vf = __builtin_shufflevector(lo, hi, 0, 1, 2, 3, 4, 5, 6, 7);
                o[dt] = MFMA32(vf, pf, o[dt]);
            }
        }
    const float il = 1.f / l; float lse = mx + log2f(l);
#pragma unroll
    for (int i = 0; i < 16; ++i) { o[0][i] *= il; o[1][i] *= il; }
    bf16* st = OST + rowq * 1024 + head * 64 + 4 * h;
    if (PASS != 0) {
        const float lse0 = LST[rowq * 16 + head]; const float ln = fmaxf(lse, lse0) + log2f(1.f + exp2f(-fabsf(lse - lse0)));
        const float wa = exp2f(lse0 - ln), wb = exp2f(lse - ln);
#pragma unroll
        for (int dt = 0; dt < 2; ++dt)
#pragma unroll
            for (int g = 0; g < 4; ++g) { const v2u pv = *(const v2u*)(st + dt * 32 + 8 * g);
                o[dt][4 * g] = o[dt][4 * g] * wb + bflo(pv.x) * wa; o[dt][4 * g + 1] = o[dt][4 * g + 1] * wb + bfhi(pv.x) * wa;
                o[dt][4 * g + 2] = o[dt][4 * g + 2] * wb + bflo(pv.y) * wa; o[dt][4 * g + 3] = o[dt][4 * g + 3] * wb + bfhi(pv.y) * wa; }
        lse = ln;
    }
    if (PASS != 2) {
#pragma unroll
        for (int dt = 0; dt < 2; ++dt)
#pragma unroll
            for (int g = 0; g < 4; ++g) { v2u pv; pv.x = cvtpk(o[dt][4 * g], o[dt][4 * g + 1]); pv.y = cvtpk(o[dt][4 * g + 2], o[dt][4 * g + 3]); *(v2u*)(st + dt * 32 + 8 * g) = pv; }
        if (h == 0) LST[rowq * 16 + head] = lse;
    } else {
        const bf16* zp = F.ZA + rowq * 1024 + head * 64 + 4 * h; bf16* yp = F.MIX + rowq * 2048 + 1024 + head * 64 + 4 * h;
#pragma unroll
        for (int dt = 0; dt < 2; ++dt)
#pragma unroll
            for (int g = 0; g < 4; ++g) { const v2u z = *(const v2u*)(zp + dt * 32 + 8 * g); v2u pv;
                pv.x = cvtpk(o[dt][4 * g] * silu_f(bflo(z.x)), o[dt][4 * g + 1] * silu_f(bfhi(z.x))); pv.y = cvtpk(o[dt][4 * g + 2] * silu_f(bflo(z.y)), o[dt][4 * g + 3] * silu_f(bfhi(z.y)));
                *(v2u*)(yp + dt * 32 + 8 * g) = pv; }
    }
}
constexpr int SP_ROW = 272;
__device__ __forceinline__ void ssd_pre_item(Frame& F, int item, bf16* CC, bf16* BT, bf16* CB) {
    const int gc = item >> 1, g = item & 1, row0 = gc * 128; int seq0, pos0, S; row_info(row0, seq0, pos0, S);
    LAS unsigned char* Bt = F.lds; LAS unsigned char* Ct = F.lds + 128 * SP_ROW;
    __syncthreads();
    for (int e = F.tid; e < 128 * 32; e += NT) {
        const int tok = e >> 5, cg = e & 31, isC = cg >> 4, n0 = (cg & 15) * 8, chan = isC * 256 + g * 128 + n0;
        float a[8]; const float* cb = F.conv_b + 1024 + chan;
#pragma unroll
        for (int q = 0; q < 8; ++q) a[q] = cb[q];
#pragma unroll
        for (int j = 0; j < 5; ++j) { const int p2 = pos0 + tok + j - 2; if (p2 < 0 || p2 >= S) continue;
            const v4u w = *(const v4u*)(F.BCR + (size_t)(seq0 + p2) * 512 + chan); const float* cw = F.conv_w + j * 1536 + 1024 + chan;
            a[0] += cw[0] * bflo(w.x); a[1] += cw[1] * bfhi(w.x); a[2] += cw[2] * bflo(w.y); a[3] += cw[3] * bfhi(w.y);
            a[4] += cw[4] * bflo(w.z); a[5] += cw[5] * bfhi(w.z); a[6] += cw[6] * bflo(w.w); a[7] += cw[7] * bfhi(w.w); }
        v4u o; o.x = pk2(silu_f(a[0]), silu_f(a[1])); o.y = pk2(silu_f(a[2]), silu_f(a[3])); o.z = pk2(silu_f(a[4]), silu_f(a[5])); o.w = pk2(silu_f(a[6]), silu_f(a[7]));
        *(LAS v4u*)((isC ? Ct : Bt) + tok * SP_ROW + n0 * 2) = o;
        if (isC) *(v4u*)(CC + (size_t)(row0 + tok) * 256 + g * 128 + n0) = o;
    }
    __syncthreads();
    const int w = F.wave, lane = F.lane, c = lane & 31, h = lane >> 5; const size_t tb = (size_t)(gc * 2 + g) * 128 * 128;
#pragma unroll
    for (int tt = 0; tt < 2; ++tt) {
        const int t = 2 * w + tt, sb = t >> 2, lb = t & 3; f32x16 acc;
#pragma unroll
        for (int i = 0; i < 16; ++i) acc[i] = 0.f;
#pragma unroll
        for (int st = 0; st < 8; ++st) { const bf16x8 a = *(LAS const bf16x8*)(Bt + (32 * sb + c) * SP_ROW + (16 * st + 8 * h) * 2);
            const bf16x8 b = *(LAS const bf16x8*)(Ct + (32 * lb + c) * SP_ROW + (16 * st + 8 * h) * 2); acc = MFMA32(a, b, acc); }
        bf16* dst = CB + tb + (size_t)(32 * lb + c) * 128 + 32 * sb + 4 * h;
#pragma unroll
        for (int gq = 0; gq < 4; ++gq) { v2u pv; pv.x = cvtpk(acc[4 * gq], acc[4 * gq + 1]); pv.y = cvtpk(acc[4 * gq + 2], acc[4 * gq + 3]); *(v2u*)(dst + 8 * gq) = pv; }
    }
    {
        const int n = F.tid & 127, sq = F.tid >> 7; bf16* dst = BT + tb + (size_t)n * 128 + 32 * sq;
#pragma unroll
        for (int q = 0; q < 4; ++q) { unsigned v[8];
#pragma unroll
            for (int i = 0; i < 8; ++i) v[i] = *(LAS const unsigned short*)(Bt + (32 * sq + 8 * q + i) * SP_ROW + n * 2);
            v4u o; o.x = v[0] | (v[1] << 16); o.y = v[2] | (v[3] << 16); o.z = v[4] | (v[5] << 16); o.w = v[6] | (v[7] << 16); *(v4u*)(dst + 8 * q) = o; }
    }
}
constexpr int SC_DIR = 40960, SC_XC = 0, SC_XDT = 8192, SC_XW = 16384, SC_SB = 24576, SC_ACL = 32768, SC_DTV = 33792, SC_WT = 34816, SC_CW = 34880;
__device__ __forceinline__ void ssd_chain_item(Frame& F, int item, const bf16* CC, const bf16* BT, const bf16* CB, bf16* PART) {
    const int xcd = item & 7, slot = item >> 3, set = ((slot >> 4) << 3) + xcd, b = set >> 1, g = set & 1, jj = slot & 15, head = g * 8 + (jj >> 1), ph = jj & 1;
    const int S = b < 4 ? 4096 : 8192, seq0 = b < 4 ? b * 4096 : M_P + (b - 4) * 8192, NC = S / 128;
    const int dir = F.wave >> 2, wq = F.wave & 3, lane = F.lane, c = lane & 31, h = lane >> 5, tq = F.tid & 255;
    LAS unsigned char* L = F.lds + dir * SC_DIR;
    const float A2 = -__expf(dir ? F.alog_b[head] : F.alog_f[head]) * 1.4426950408889634f; const float dtb = dir ? F.dtb_b[head] : F.dtb_f[head]; const float Dh = F.dskip[head];
    const int chb = head * 64 + ph * 32;
    __syncthreads();
    for (int e = tq; e < 192; e += 256) { const int j = e >> 5, p = e & 31; ((LAS float*)(L + SC_CW))[e] = j < 5 ? F.conv_w[j * 1536 + chb + p] : F.conv_b[chb + p]; }
    for (int e = tq; e < 2048; e += 256) ((LAS unsigned*)(L + SC_SB))[e] = 0u;
    __syncthreads();
    f32x16 accS;
#pragma unroll
    for (int i = 0; i < 16; ++i) accS[i] = 0.f;
    const int vt_off = ((lane & 15) >> 2) * 64 + (16 * ((lane >> 4) & 1) + 4 * (lane & 3)) * 2 + 8 * h * 64;
    for (int step = 0; step < NC; ++step) {
        const int chunk = dir ? NC - 1 - step : step, row0 = seq0 + chunk * 128, par = step & 1; const size_t tb = (size_t)((row0 >> 7) * 2 + g) * 128 * 128;
        LAS float* ACL = (LAS float*)(L + SC_ACL) + par * 128; LAS float* DTV = (LAS float*)(L + SC_DTV) + par * 128; LAS float* WT = (LAS float*)(L + SC_WT) + par * 4;
        const int lrow = 32 * wq + c;
        bf16x8 Cf[8], Bf[8], Gf[4][2];
#pragma unroll
        for (int st = 0; st < 8; ++st) { Cf[st] = *(const bf16x8*)(CC + (size_t)(row0 + lrow) * 256 + g * 128 + 16 * st + 8 * h); Bf[st] = *(const bf16x8*)(BT + tb + (size_t)lrow * 128 + 16 * st + 8 * h); }
#pragma unroll
        for (int sb = 0; sb < 4; ++sb) { const bool need = dir ? (sb >= wq) : (sb <= wq);
            if (need) {
#pragma unroll
                for (int st = 0; st < 2; ++st) Gf[sb][st] = *(const bf16x8*)(CB + tb + (size_t)lrow * 128 + 32 * sb + 16 * st + 8 * h); }
            else {
#pragma unroll
                for (int st = 0; st < 2; ++st) Gf[sb][st] = (bf16x8){0, 0, 0, 0, 0, 0, 0, 0}; } }
        if (wq < 2) { const int l = 64 * wq + lane; const float raw = F.DT[(size_t)(row0 + l) * 32 + dir * 16 + head] + dtb; const float dt = raw > 20.f ? raw : log1pf(__expf(raw));
            float v = dt * A2;
            if (dir == 0) {
#pragma unroll
                for (int off = 1; off < 64; off <<= 1) { const float t = __shfl_up(v, off); if (lane >= off) v += t; }
                if (lane == 63) WT[wq] = v;
            } else {
#pragma unroll
                for (int off = 1; off < 64; off <<= 1) { const float t = __shfl_down(v, off); if (lane + off < 64) v += t; }
                if (lane == 0) WT[wq] = v;
            }
            ACL[l] = v; DTV[l] = dt; }
        const int tok = tq >> 1, p0 = (tq & 1) * 16; float xc[16];
        { const LAS float* cw = (const LAS float*)(L + SC_CW);
#pragma unroll
          for (int q = 0; q < 16; ++q) xc[q] = cw[160 + p0 + q];
          const int pos = (row0 - seq0) + tok;
#pragma unroll
          for (int j = 0; j < 5; ++j) { const int p2 = pos + j - 2; if (p2 < 0 || p2 >= S) continue;
              const v4u* src = (const v4u*)(F.XS + (size_t)(seq0 + p2) * 1024 + chb + p0); const v4u w0 = src[0], w1 = src[1]; const LAS float* cj = cw + j * 32 + p0;
              xc[0] += cj[0] * bflo(w0.x); xc[1] += cj[1] * bfhi(w0.x); xc[2] += cj[2] * bflo(w0.y); xc[3] += cj[3] * bfhi(w0.y);
              xc[4] += cj[4] * bflo(w0.z); xc[5] += cj[5] * bfhi(w0.z); xc[6] += cj[6] * bflo(w0.w); xc[7] += cj[7] * bfhi(w0.w);
              xc[8] += cj[8] * bflo(w1.x); xc[9] += cj[9] * bfhi(w1.x); xc[10] += cj[10] * bflo(w1.y); xc[11] += cj[11] * bfhi(w1.y);
              xc[12] += cj[12] * bflo(w1.z); xc[13] += cj[13] * bfhi(w1.z); xc[14] += cj[14] * bflo(w1.w); xc[15] += cj[15] * bfhi(w1.w); }
#pragma unroll
          for (int q = 0; q < 16; ++q) xc[q] = silu_f(xc[q]); }
        __syncthreads();
        const float wt0 = WT[0], wt1 = WT[1];
        const float tot = wt0 + wt1;
        {
            const float dt = DTV[tok]; const float acl = ACL[tok] + (dir ? (tok < 64 ? wt1 : 0.f) : (tok >= 64 ? wt0 : 0.f)); const float wsc = dt * exp2f(tot - acl);
            v4u a0, a1, b0, b1, c0, c1;
            a0.x = cvtpk(xc[0], xc[1]); a0.y = cvtpk(xc[2], xc[3]); a0.z = cvtpk(xc[4], xc[5]); a0.w = cvtpk(xc[6], xc[7]); a1.x = cvtpk(xc[8], xc[9]); a1.y = cvtpk(xc[10], xc[11]); a1.z = cvtpk(xc[12], xc[13]); a1.w = cvtpk(xc[14], xc[15]);
            b0.x = cvtpk(xc[0] * dt, xc[1] * dt); b0.y = cvtpk(xc[2] * dt, xc[3] * dt); b0.z = cvtpk(xc[4] * dt, xc[5] * dt); b0.w = cvtpk(xc[6] * dt, xc[7] * dt);
            b1.x = cvtpk(xc[8] * dt, xc[9] * dt); b1.y = cvtpk(xc[10] * dt, xc[11] * dt); b1.z = cvtpk(xc[12] * dt, xc[13] * dt); b1.w = cvtpk(xc[14] * dt, xc[15] * dt);
            c0.x = cvtpk(xc[0] * wsc, xc[1] * wsc); c0.y = cvtpk(xc[2] * wsc, xc[3] * wsc); c0.z = cvtpk(xc[4] * wsc, xc[5] * wsc); c0.w = cvtpk(xc[6] * wsc, xc[7] * wsc);
            c1.x = cvtpk(xc[8] * wsc, xc[9] * wsc); c1.y = cvtpk(xc[10] * wsc, xc[11] * wsc); c1.z = cvtpk(xc[12] * wsc, xc[13] * wsc); c1.w = cvtpk(xc[14] * wsc, xc[15] * wsc);
            LAS v4u* d0 = (LAS v4u*)(L + SC_XC + tok * 64 + p0 * 2); d0[0] = a0; d0[1] = a1;
            LAS v4u* d1 = (LAS v4u*)(L + SC_XDT + tok * 64 + p0 * 2); d1[0] = b0; d1[1] = b1;
            LAS v4u* d2 = (LAS v4u*)(L + SC_XW + tok * 64 + p0 * 2); d2[0] = c0; d2[1] = c1;
#pragma unroll
            for (int gq = 0; gq < 4; ++gq) { v2u pv; pv.x = cvtpk(accS[4 * gq], accS[4 * gq + 1]); pv.y = cvtpk(accS[4 * gq + 2], accS[4 * gq + 3]); *(LAS v2u*)(L + SC_SB + lrow * 64 + (8 * gq + 4 * h) * 2) = pv; }
        }
        __syncthreads();
        f32x16 accY;
#pragma unroll
        for (int i = 0; i < 16; ++i) accY[i] = 0.f;
#pragma unroll
        for (int st = 0; st < 8; ++st) { LAS const unsigned char* ap = L + SC_SB + 16 * st * 64 + vt_off; const s16x4 lo = vtr(ap), hi = vtr(ap + 4 * 64);
            accY = MFMA32(__builtin_shufflevector(lo, hi, 0, 1, 2, 3, 4, 5, 6, 7), Cf[st], accY); }
        const float acl_l = ACL[lrow] + (dir ? (lrow < 64 ? wt1 : 0.f) : (lrow >= 64 ? wt0 : 0.f));
        { const float sc = exp2f(acl_l);
#pragma unroll
          for (int i = 0; i < 16; ++i) accY[i] *= sc; }
#pragma unroll
        for (int sb = 0; sb < 4; ++sb) { const bool need = dir ? (sb >= wq) : (sb <= wq);
            if (need) {
#pragma unroll
                for (int st = 0; st < 2; ++st) { const int s0 = 32 * sb + 16 * st + 8 * h; const float fix = dir ? (s0 < 64 ? wt1 : 0.f) : (s0 >= 64 ? wt0 : 0.f);
                    const f32x4 e0 = *(const LAS f32x4*)(ACL + s0), e1 = *(const LAS f32x4*)(ACL + s0 + 4); const bf16x8 cb = Gf[sb][st]; const v4u cw = __builtin_bit_cast(v4u, cb);
                    float gv[8]; gv[0] = bflo(cw.x); gv[1] = bfhi(cw.x); gv[2] = bflo(cw.y); gv[3] = bfhi(cw.y); gv[4] = bflo(cw.z); gv[5] = bfhi(cw.z); gv[6] = bflo(cw.w); gv[7] = bfhi(cw.w);
                    const float base = acl_l - fix;
#pragma unroll
                    for (int j = 0; j < 8; ++j) { const float as = j < 4 ? e0[j] : e1[j - 4]; const int srel = s0 + j - 32 * wq;
                        const bool ok = dir ? (srel >= c) : (srel <= c); gv[j] = ok ? gv[j] * exp2f(base - as) : 0.f; }
                    v4u gw; gw.x = cvtpk(gv[0], gv[1]); gw.y = cvtpk(gv[2], gv[3]); gw.z = cvtpk(gv[4], gv[5]); gw.w = cvtpk(gv[6], gv[7]);
                    LAS const unsigned char* ap = L + SC_XDT + (32 * sb + 16 * st) * 64 + vt_off; const s16x4 lo = vtr(ap), hi = vtr(ap + 4 * 64);
                    accY = MFMA32(__builtin_shufflevector(lo, hi, 0, 1, 2, 3, 4, 5, 6, 7), __builtin_bit_cast(bf16x8, gw), accY); } } }
        { const float dsc = exp2f(tot);
#pragma unroll
          for (int i = 0; i < 16; ++i) accS[i] *= dsc; }
#pragma unroll
        for (int st = 0; st < 8; ++st) { LAS const unsigned char* ap = L + SC_XW + 16 * st * 64 + vt_off; const s16x4 lo = vtr(ap), hi = vtr(ap + 4 * 64);
            accS = MFMA32(__builtin_shufflevector(lo, hi, 0, 1, 2, 3, 4, 5, 6, 7), Bf[st], accS); }
        const size_t orow = (size_t)(row0 + lrow);
        if (step < NC / 2) {
            bf16* pp = PART + orow * 1024 + chb + 4 * h;
#pragma unroll
            for (int gq = 0; gq < 4; ++gq) { v2u pv; pv.x = cvtpk(accY[4 * gq], accY[4 * gq + 1]); pv.y = cvtpk(accY[4 * gq + 2], accY[4 * gq + 3]); *(v2u*)(pp + 8 * gq) = pv; }
        } else {
            const bf16* pp = PART + orow * 1024 + chb + 4 * h; bf16* zp = F.MIX + orow * 2048 + chb + 4 * h; float ss = 0.f;
#pragma unroll
            for (int gq = 0; gq < 4; ++gq) { const v2u pv = *(const v2u*)(pp + 8 * gq), zv = *(const v2u*)(zp + 8 * gq); const v2u xv = *(const LAS v2u*)(L + SC_XC + lrow * 64 + (8 * gq + 4 * h) * 2);
                const float y0 = (accY[4 * gq] + bflo(pv.x) + Dh * bflo(xv.x)) * silu_f(bflo(zv.x)), y1 = (accY[4 * gq + 1] + bfhi(pv.x) + Dh * bfhi(xv.x)) * silu_f(bfhi(zv.x));
                const float y2 = (accY[4 * gq + 2] + bflo(pv.y) + Dh * bflo(xv.y)) * silu_f(bflo(zv.y)), y3 = (accY[4 * gq + 3] + bfhi(pv.y) + Dh * bfhi(xv.y)) * silu_f(bfhi(zv.y));
                ss += (y0 * y0 + y1 * y1) + (y2 * y2 + y3 * y3); v2u ov; ov.x = cvtpk(y0, y1); ov.y = cvtpk(y2, y3); *(v2u*)(zp + 8 * gq) = ov; }
            ss += __shfl_xor(ss, 32);
            if (h == 0) atomicAdd(F.SSQ_SSD + orow, ss);
        }
    }
}
#ifndef MK_ONE_LAUNCH
#define MK_ONE_LAUNCH 1
#endif
constexpr int NPHASE = 8;
__global__ void __launch_bounds__(NT, 2) hybrid_fwd(Args args) {
    extern __shared__ __attribute__((aligned(16))) unsigned char lds[];
    Frame F;
    F.lds = (LAS unsigned char*)lds; F.tid = threadIdx.x; F.lane = F.tid & 63; F.wave = __builtin_amdgcn_readfirstlane(F.tid >> 6); F.G = gridDim.x; F.bid = blockIdx.x;
    F.xp = args.in[0]; F.xsm = args.in[1]; F.w_in = args.in[2]; F.conv_w = args.in[3]; F.conv_b = args.in[4]; F.dtb_f = args.in[5]; F.dtb_b = args.in[6];
    F.alog_f = args.in[7]; F.alog_b = args.in[8]; F.dskip = args.in[9]; F.norm_ssd = args.in[10]; F.norm_in = args.in[11]; F.w_out = args.in[12]; F.norm_f = args.in[13];
    F.out = args.out; F.ws = args.ws; unsigned char* ws = args.ws;
    F.WIN = (bf16*)(ws + WS_WIN); F.WOUT = (bf16*)(ws + WS_WOUT); F.ROPE = (float*)(ws + WS_ROPE); F.DT = (float*)(ws + WS_DT); F.MIX = (bf16*)(ws + WS_MIX);
    F.KB = (bf16*)(ws + WS_K); F.VB = (bf16*)(ws + WS_V); F.ZA = (bf16*)(ws + WS_ZA); F.XS = (bf16*)(ws + WS_XS); F.BCR = (bf16*)(ws + WS_BCR);
    F.XN = (bf16*)args.out;
    F.XC = (bf16*)args.out; F.YF = (bf16*)(ws + WS_FREE);
    F.SSQ_SSD = (float*)(ws + WS_CTL + CTL_SSQ_SSD); F.SSQ_OUT = (float*)(ws + WS_CTL + CTL_SSQ_OUT);
    for (int u = F.tid; u < (LDS_BYTES - LDSCTL_OFF) / 4; u += NT) ((LAS unsigned*)(F.lds + LDSCTL_OFF))[u] = 0u;
    __syncthreads();
    XcdBarrier bar; bar.bar = (unsigned*)(ws + WS_CTL) + CW_BAR; bar.x = 0; bar.st = nullptr;
    if (MK_ONE_LAUNCH) bar = xcd_barrier_post((unsigned*)(ws + WS_CTL) + CW_BAR, (volatile LAS unsigned*)(F.lds + MISC_OFF) + 8);
    const int lo = args.ph_lo, hi = args.ph_hi;
#define IN(k) (lo <= (k) && (k) < hi)
#define SEAM(k) do { if (IN(k) && IN((k) + 1)) xcd_barrier(bar); } while (0)
    if (IN(0)) { p0_prologue(F); SEAM(0); }
    if (IN(1)) {
        pg8::Gemm g{F.XN, F.WIN, M, NPAD, DM}; pg8::StaticOrder S; S.init(M, NPAD, F.G, F.bid);
        pg8::EpiInProj E{F.MIX, F.KB, F.VB, F.ZA, F.XS, F.BCR, F.DT, F.ROPE};
        pg8::gemm_phase<pg8::EpiInProj, pg8::StaticOrder, true, true>(F.lds + RING_OFF, g, S, E);
        SEAM(1);
    }
    bf16* OST = (bf16*)(ws + WS_FREE); float* LST = (float*)(ws + WS_FREE + 96 * MiB);
    bf16* PART = (bf16*)args.out; bf16* CC = (bf16*)((unsigned char*)args.out + 96 * MiB); bf16* BT = (bf16*)((unsigned char*)args.out + 120 * MiB); bf16* CBm = (bf16*)((unsigned char*)args.out + 144 * MiB);
    if (IN(2)) { for (int it = F.bid; it < 768; it += F.G) ssd_pre_item(F, it, CC, BT, CBm);
                 for (int u = F.bid; u < AT_UNITS; u += F.G) attn_unit<16, 0>(F, u, OST, LST); SEAM(2); }
    if (IN(3)) { for (int u = F.bid; u < AT_UNITS; u += F.G) attn_unit<4, 1>(F, u, OST, LST); SEAM(3); }
    if (IN(4)) {
        for (int it = F.bid; it < 256; it += F.G) ssd_chain_item(F, it, CC, BT, CBm, PART);
        unsigned* ctr = (unsigned*)(ws + WS_CTL) + CW_QCTR; volatile LAS unsigned* shu = (volatile LAS unsigned*)(F.lds + MISC_OFF) + 16;
        for (;;) { __syncthreads(); if (F.tid == 0) *shu = atomicAdd(ctr, 1u); __syncthreads(); const int u = (int)*shu; if (u >= AT_UNITS) break; attn_unit<1, 2>(F, u, OST, LST); }
        SEAM(4);
    }
    if (IN(5)) { nv_ssd_norm(F); SEAM(5); }
    if (IN(6)) {
        pg8::Gemm g{F.MIX, F.WOUT, M, DM, KOUT}; pg8::StaticOrder S; S.init(M, DM, F.G, F.bid);
        pg8::EpiOutProj E{F.xp, F.xsm, F.out, F.SSQ_OUT};
        pg8::gemm_phase<pg8::EpiOutProj, pg8::StaticOrder, true, true>(F.lds + RING_OFF, g, S, E);
        SEAM(6);
    }
    if (IN(7)) final_norm(F);
#undef IN
#undef SEAM
}
extern "C" void kernel_launch(void* const* d_in, const int* in_sizes, int n_in, void* d_out, int out_size, void* d_ws, size_t ws_size, hipStream_t stream) {
    static int grid = 0;
    if (grid == 0) {
        if (n_in != 14 || out_size != M * DM || ws_size < WS_END) { fprintf(stderr, "kernel_launch: unexpected problem: n_in %d out %d ws %zu\n", n_in, out_size, ws_size); grid = -1; return; }
        int dev = 0, cus = 0, per_cu = 0;
        if (hipGetDevice(&dev) != hipSuccess || hipDeviceGetAttribute(&cus, hipDeviceAttributeMultiprocessorCount, dev) != hipSuccess) { grid = -1; return; }
        if (hipFuncSetAttribute((const void*)hybrid_fwd, hipFuncAttributeMaxDynamicSharedMemorySize, LDS_BYTES) != hipSuccess) { fprintf(stderr, "kernel_launch: hipFuncSetAttribute failed\n"); grid = -1; return; }
        if (hipOccupancyMaxActiveBlocksPerMultiprocessor(&per_cu, (const void*)hybrid_fwd, NT, LDS_BYTES) != hipSuccess || per_cu < 1) { fprintf(stderr, "kernel_launch: occupancy query says %d\n", per_cu); per_cu = 1; }
        (void)hipGetLastError();
        grid = cus;
    }
    if (grid < 0) return;
    (void)hipMemsetAsync((char*)d_ws + WS_CTL, 0, CTL_ZERO_BYTES, stream);
    Args a{};
    for (int i = 0; i < 14; ++i) a.in[i] = (const float*)d_in[i];
    a.out = (float*)d_out; a.ws = (unsigned char*)d_ws;
#if MK_ONE_LAUNCH
    a.ph_lo = 0; a.ph_hi = NPHASE;
    hipLaunchKernelGGL(hybrid_fwd, dim3(grid), dim3(NT), LDS_BYTES, stream, a);
#else
    for (int p = 0; p < NPHASE; ++p) { a.ph_lo = p; a.ph_hi = p + 1; hipLaunchKernelGGL(hybrid_fwd, dim3(grid), dim3(NT), LDS_BYTES, stream, a); }
#endif
}
```

```cpp
#include <hip/hip_runtime.h>
#include <cstdio>
#include <cstdint>
#include <cmath>
namespace pg8 {
#define PG8_LAS __attribute__((address_space(3)))
typedef unsigned short bf16_t;
typedef short bf16x8 __attribute__((ext_vector_type(8)));
typedef float f32x4 __attribute__((ext_vector_type(4)));
typedef unsigned u32x4 __attribute__((ext_vector_type(4)));
constexpr int BM = 256, BK = 64, HALF = 128, HTB = HALF * BK * 2  , STAGE_BYTES = 8 * HTB, NXCD = 8, WGM = 8;

__host__ __device__ __forceinline__ int lds_byte(int r, int c) { const int st = (r >> 4) * 2 + (c >> 5), rr = r & 15, cc = c & 31, ob = rr * 64 + cc * 2; return st * 1024 + (ob ^ (((ob >> 9) & 1) << 5)); }
__host__ __device__ __forceinline__ void stage_rc(int b, int& R, int& C) { const int st = b / 1024, sb = b % 1024, swz = sb ^ (((sb >> 9) & 1) << 5); R = (st >> 1) * 16 + swz / 64; C = (st & 1) * 32 + (swz % 64) / 2; }
__host__ __device__ __forceinline__ int perm32(int rho) { const int n = rho >> 4, i = rho & 15; return 8 * (i >> 2) + 4 * n + (i & 3); }

struct Unit { int pm, pn; };
struct Gemm { const bf16_t* A; const bf16_t* Bt; int M, N, K; };

struct StaticOrder {
    int nM, nN, nwg, G, c;
    __host__ __device__ void init(int M, int N, int G_, int c_) { nM = M / BM; nN = N / BM; nwg = nM * nN; G = G_; c = c_; }
    __host__ __device__ bool next(int i, Unit& u) const {
        const long L = (long)i * G + c; if (L >= nwg) return false;
        int wgid = (int)L; { const int q = nwg / NXCD, r = nwg % NXCD, xcd = wgid % NXCD, off = wgid / NXCD; wgid = (xcd < r ? xcd * (q + 1) : r * (q + 1) + (xcd - r) * q) + off; }
        const int nig = WGM * nN, gid = wgid / nig, fm = gid * WGM, gsz = (nM - fm) < WGM ? (nM - fm) : WGM;
        u.pm = fm + ((wgid % nig) % gsz); u.pn = (wgid % nig) / gsz; return true;
    }
    __device__ __forceinline__ void a_ready(const Unit&) const {}
    __device__ __forceinline__ void done(const Unit&) const {}
};

__device__ __forceinline__ unsigned cvt_pk_bf16(float lo, float hi) { unsigned r; asm volatile("v_cvt_pk_bf16_f32 %0, %1, %2" : "=v"(r) : "v"(lo), "v"(hi)); return r; }
typedef float f32x2 __attribute__((ext_vector_type(2)));
__device__ __forceinline__ f32x2 gelu_pk(f32x2 v) {
    const f32x2 av = __builtin_elementwise_abs(v), d = av * 0.2316418882f + 1.0f;
    f32x2 t; t.x = __builtin_amdgcn_rcpf(d.x); t.y = __builtin_amdgcn_rcpf(d.y);
    f32x2 q = t * 0.5307027145f + (-0.7265760135f); q = q * t + 0.7107068705f; q = q * t + (-0.142248368f); q = q * t + 0.127414796f; q = q * t;
    const f32x2 s = (v * v) * (-0.72134752044f);
    f32x2 e; e.x = __builtin_amdgcn_exp2f(s.x); e.y = __builtin_amdgcn_exp2f(s.y);
    const f32x2 m = v * (q * e), r = v - m;
    f32x2 o; o.x = v.x < 0.f ? m.x : r.x; o.y = v.y < 0.f ? m.y : r.y; return o;
}

struct EpiInProj {
    static constexpr bool PERM = true, AFTER_DRAIN = false;
    bf16_t *MIX, *KB, *VB, *ZA, *XS, *BCR; float* DT; const float* rope;
    __device__ __forceinline__ void operator()(const f32x4 (&acc)[2][2][4][2], const Unit& u, int wr, int wc, int fr, int fq) const {
        const int row0 = u.pm * BM + wr * 64 + fr; const int pn = u.pn;
        if (pn == 26) {
            if (wc == 0) {
#pragma unroll
                for (int ai = 0; ai < 2; ++ai)
#pragma unroll
                    for (int m = 0; m < 4; ++m) { float* rp = DT + (size_t)(row0 + ai * HALF + m * 16) * 32 + 8 * fq;
                        *(f32x4*)rp = acc[ai][0][m][0]; *(f32x4*)(rp + 4) = acc[ai][0][m][1]; }
            }
            return;
        }
        bf16_t* base; int ldc, colt, mode = 0;
        if (pn < 4)       { base = MIX + 1024; ldc = 2048; colt = pn * 256; mode = 1; }
        else if (pn < 8)  { base = KB;  ldc = 1024; colt = (pn - 4) * 256; mode = 2; }
        else if (pn < 12) { base = VB;  ldc = 1024; colt = (pn - 8) * 256; }
        else if (pn < 16) { base = ZA;  ldc = 1024; colt = (pn - 12) * 256; }
        else if (pn < 20) { base = MIX; ldc = 2048; colt = (pn - 16) * 256; }
        else if (pn < 24) { base = XS;  ldc = 1024; colt = (pn - 20) * 256; }
        else              { base = BCR; ldc = 512;  colt = (pn - 24) * 256; }
        const int col0 = colt + wc * 32 + 8 * fq;
        const float qs = (mode == 1) ? 0.125f * 1.4426950408889634f : 1.0f;
        const int j0 = (wc & 1) * 16 + 4 * fq;
#pragma unroll
        for (int ai = 0; ai < 2; ++ai)
#pragma unroll
            for (int m = 0; m < 4; ++m) {
                const int row = row0 + ai * HALF + m * 16;
                bf16_t* rowp = base + (size_t)row * ldc + col0;
                f32x4 cs0 = {1.f, 0.f, 1.f, 0.f}, cs1 = {1.f, 0.f, 1.f, 0.f};
                if (mode != 0) { const int pos = row < 16384 ? (row & 4095) : ((row - 16384) & 8191);
                    const float* rp = rope + ((size_t)pos * 32 + j0) * 2; cs0 = *(const f32x4*)rp; cs1 = *(const f32x4*)(rp + 4); }
#pragma unroll
                for (int bj = 0; bj < 2; ++bj) {
                    f32x4 v0 = acc[ai][bj][m][0], v1 = acc[ai][bj][m][1];
                    if (mode != 0) {
                        f32x4 a, b;
                        a[0] = v0[0] * cs0[0] - v0[1] * cs0[1]; a[1] = v0[1] * cs0[0] + v0[0] * cs0[1];
                        a[2] = v0[2] * cs0[2] - v0[3] * cs0[3]; a[3] = v0[3] * cs0[2] + v0[2] * cs0[3];
                        b[0] = v1[0] * cs1[0] - v1[1] * cs1[1]; b[1] = v1[1] * cs1[0] + v1[0] * cs1[1];
                        b[2] = v1[2] * cs1[2] - v1[3] * cs1[3]; b[3] = v1[3] * cs1[2] + v1[2] * cs1[3];
                        v0 = a * qs; v1 = b * qs;
                    }
                    u32x4 w; w.x = cvt_pk_bf16(v0[0], v0[1]); w.y = cvt_pk_bf16(v0[2], v0[3]); w.z = cvt_pk_bf16(v1[0], v1[1]); w.w = cvt_pk_bf16(v1[2], v1[3]);
                    *(u32x4*)(rowp + bj * HALF) = w;
                }
            }
    }
};
struct EpiOutProj {
    static constexpr bool PERM = false, AFTER_DRAIN = false;
    const float* xp; const float* xs; float* out; float* ssq;
    __device__ __forceinline__ void operator()(const f32x4 (&acc)[2][2][4][2], const Unit& u, int wr, int wc, int fr, int fq) const {
        const int row0 = u.pm * BM + wr * 64 + fr; const int col0 = u.pn * BM + wc * 32 + 4 * fq;
#pragma unroll
        for (int ai = 0; ai < 2; ++ai)
#pragma unroll
            for (int m = 0; m < 4; ++m) {
                const int row = row0 + ai * HALF + m * 16;
                const float* xr = (row < 16384 ? xp + (size_t)row * 1024 : xs + (size_t)(row - 16384) * 1024) + col0;
                float* orow = out + (size_t)row * 1024 + col0; float s = 0.f;
#pragma unroll
                for (int bj = 0; bj < 2; ++bj)
#pragma unroll
                    for (int n = 0; n < 2; ++n) { const f32x4 o = *(const f32x4*)(xr + bj * HALF + n * 16) + acc[ai][bj][m][n];
                        *(f32x4*)(orow + bj * HALF + n * 16) = o; s += (o[0] * o[0] + o[1] * o[1]) + (o[2] * o[2] + o[3] * o[3]); }
                s += __shfl_xor(s, 16); s += __shfl_xor(s, 32);
                if (fq == 0) atomicAdd(ssq + row, s);
            }
    }
};
template <class Epi, class Sched, bool ALIGN_EPI = false, bool SP2 = false>
__device__ __forceinline__ void gemm_phase(PG8_LAS unsigned char* lds, const Gemm g, const Sched& S, const Epi& E) {
    const int tid = threadIdx.x, wid = __builtin_amdgcn_readfirstlane(tid >> 6), lane = tid & 63, wr = wid >> 2, wc = wid & 3, fr = lane & 15, fq = lane >> 4;
    const int K = g.K, nt = K / BK;
    unsigned voffA[2], voffB[2];
#pragma unroll
    for (int i = 0; i < 2; ++i) { int R, C; stage_rc(tid * 16 + i * 8192, R, C); const int Rb = Epi::PERM ? ((R & ~31) + perm32(R & 31)) : R;
        voffA[i] = (unsigned)(R * K + C) * 2u; voffB[i] = (unsigned)(Rb * K + C) * 2u; }
    const size_t kstep = (size_t)(BK * 2);
    const size_t hstep = (size_t)HALF * K * 2;
    const size_t tstep = 2 * hstep;
    const unsigned ldsw = (unsigned)wid * 1024u;
    const int aoff = lds_byte(wr * 64 + fr, fq * 8), boff = lds_byte(wc * 32 + fr, fq * 8);
#define PG8_SA(b, h) (((b) * 2 + (h)) * HTB)
#define PG8_SB(b, h) ((4 + (b) * 2 + (h)) * HTB)
#define PG8_STAGE(bufoff, gbase, voff) do { _Pragma("unroll") for (int _i = 0; _i < 2; ++_i) \
        __builtin_amdgcn_global_load_lds((const unsigned*)((const char*)(gbase) + (voff)[_i]), (PG8_LAS unsigned*)(lds + (bufoff) + ldsw + _i * 8192), 16, 0, 0); } while (0)
#define PG8_LDA(dst, b, h) do { _Pragma("unroll") for (int m = 0; m < 4; ++m) _Pragma("unroll") for (int k = 0; k < 2; ++k) dst[m][k] = *(const PG8_LAS bf16x8*)(lds + PG8_SA(b, h) + aoff + m * 2048 + k * 1024); } while (0)
#define PG8_LDB(dst, b, h) do { _Pragma("unroll") for (int n = 0; n < 2; ++n) _Pragma("unroll") for (int k = 0; k < 2; ++k) dst[n][k] = *(const PG8_LAS bf16x8*)(lds + PG8_SB(b, h) + boff + n * 2048 + k * 1024); } while (0)
#define PG8_MMA(ai, bj, At, Bt) do { __builtin_amdgcn_s_setprio(1); _Pragma("unroll") for (int m = 0; m < 4; ++m) _Pragma("unroll") for (int n = 0; n < 2; ++n) _Pragma("unroll") for (int k = 0; k < 2; ++k) \
        acc[ai][bj][m][n] = __builtin_amdgcn_mfma_f32_16x16x32_bf16(Bt[n][k], At[m][k], acc[ai][bj][m][n], 0, 0, 0); __builtin_amdgcn_s_setprio(0); } while (0)
#define PG8_WAIT_V(n) asm volatile("s_waitcnt vmcnt(" #n ")" ::: "memory")
#define PG8_WAIT_L(n) asm volatile("s_waitcnt lgkmcnt(" #n ")" ::: "memory")
#define PG8_BAR __builtin_amdgcn_s_barrier()
#define PG8_SCHED __builtin_amdgcn_sched_barrier(0)
    Unit cur, nxt; int ui = 0;
    if (!S.next(0, cur)) return;
    f32x4 acc[2][2][4][2];
#pragma unroll
    for (int a = 0; a < 2; ++a)
#pragma unroll
        for (int b = 0; b < 2; ++b)
#pragma unroll
            for (int m = 0; m < 4; ++m)
#pragma unroll
                for (int n = 0; n < 2; ++n) acc[a][b][m][n] = (f32x4){0.f, 0.f, 0.f, 0.f};
    bf16x8 At[4][2], B0[2][2], B1[2][2];
    const char* cA = (const char*)g.A + (size_t)cur.pm * tstep; const char* cB = (const char*)g.Bt + (size_t)cur.pn * tstep;
    S.a_ready(cur);
    if constexpr (SP2) {
        PG8_STAGE(PG8_SB(0, 0), cB, voffB); PG8_STAGE(PG8_SB(0, 1), cB + hstep, voffB); PG8_STAGE(PG8_SA(0, 0), cA, voffA); PG8_STAGE(PG8_SA(0, 1), cA + hstep, voffA);
        if (wr == 1) PG8_BAR;
        PG8_WAIT_V(2); PG8_BAR;
        PG8_STAGE(PG8_SB(1, 0), cB + kstep, voffB); PG8_STAGE(PG8_SA(1, 0), cA + kstep, voffA); PG8_STAGE(PG8_SB(1, 1), cB + hstep + kstep, voffB);
        PG8_WAIT_V(6); PG8_BAR;
    } else {
        PG8_STAGE(PG8_SB(0, 0), cB, voffB); PG8_STAGE(PG8_SA(0, 0), cA, voffA); PG8_STAGE(PG8_SB(0, 1), cB + hstep, voffB); PG8_STAGE(PG8_SA(0, 1), cA + hstep, voffA);
        if (wr == 1) PG8_BAR;
        PG8_WAIT_V(4); PG8_BAR;
        PG8_STAGE(PG8_SB(1, 0), cB + kstep, voffB); PG8_STAGE(PG8_SA(1, 0), cA + kstep, voffA); PG8_STAGE(PG8_SB(1, 1), cB + hstep + kstep, voffB);
        PG8_WAIT_V(6); PG8_BAR;
    }
    for (;;) {
        const bool has_next = S.next(ui + 1, nxt);
        const char* nA = has_next ? (const char*)g.A + (size_t)nxt.pm * tstep : cA; const char* nB = has_next ? (const char*)g.Bt + (size_t)nxt.pn * tstep : cB;
        for (int t = 0; t < nt; t += 2) {
            const bool last = (t == nt - 2);
            const char* a1 = cA + (size_t)(t + 1) * kstep;
            const char* a2 = last ? nA : cA + (size_t)(t + 2) * kstep; const char* b2 = last ? nB : cB + (size_t)(t + 2) * kstep;
            const char* a3 = a2 + kstep; const char* b3 = b2 + kstep;
            if (last && has_next) S.a_ready(nxt);
            if constexpr (SP2) {
            PG8_LDB(B0, 0, 0); PG8_LDB(B1, 0, 1); PG8_SCHED; PG8_LDA(At, 0, 0); PG8_STAGE(PG8_SA(1, 1), a1 + hstep, voffA);
            PG8_WAIT_V(8); PG8_WAIT_L(0); PG8_BAR; PG8_MMA(0, 0, At, B0); PG8_MMA(0, 1, At, B1); PG8_BAR; PG8_SCHED;
            PG8_LDA(At, 0, 1); PG8_STAGE(PG8_SB(0, 0), b2, voffB); PG8_STAGE(PG8_SB(0, 1), b2 + hstep, voffB); PG8_STAGE(PG8_SA(0, 0), a2, voffA);
            PG8_WAIT_V(8); PG8_WAIT_L(0); PG8_BAR; PG8_MMA(1, 0, At, B0); PG8_MMA(1, 1, At, B1); PG8_BAR; PG8_SCHED;
            PG8_LDB(B0, 1, 0); PG8_LDB(B1, 1, 1); PG8_SCHED; PG8_LDA(At, 1, 0); PG8_STAGE(PG8_SA(0, 1), a2 + hstep, voffA);
            PG8_WAIT_V(8); PG8_WAIT_L(0); PG8_BAR; PG8_MMA(0, 0, At, B0); PG8_MMA(0, 1, At, B1); PG8_BAR; PG8_SCHED;
            PG8_LDA(At, 1, 1); PG8_STAGE(PG8_SB(1, 0), b3, voffB); PG8_STAGE(PG8_SB(1, 1), b3 + hstep, voffB); PG8_STAGE(PG8_SA(1, 0), a3, voffA);
            PG8_WAIT_V(8); PG8_WAIT_L(0); PG8_BAR; PG8_MMA(1, 0, At, B0); PG8_MMA(1, 1, At, B1); PG8_BAR; PG8_SCHED;
            } else {
            PG8_LDB(B0, 0, 0); PG8_SCHED; PG8_LDA(At, 0, 0); PG8_STAGE(PG8_SA(1, 1), a1 + hstep, voffA);
            PG8_WAIT_L(8); PG8_BAR; PG8_WAIT_L(0); PG8_MMA(0, 0, At, B0); PG8_BAR; PG8_SCHED;
            PG8_LDB(B1, 0, 1); PG8_STAGE(PG8_SB(0, 0), b2, voffB);
            PG8_BAR; PG8_WAIT_L(0); PG8_MMA(0, 1, At, B1); PG8_BAR;
            PG8_LDA(At, 0, 1); PG8_STAGE(PG8_SA(0, 0), a2, voffA);
            PG8_BAR; PG8_WAIT_L(0); PG8_MMA(1, 0, At, B0); PG8_BAR; PG8_SCHED;
            PG8_STAGE(PG8_SB(0, 1), b2 + hstep, voffB);
            PG8_WAIT_V(6); PG8_BAR; PG8_MMA(1, 1, At, B1); PG8_BAR;
            PG8_LDB(B0, 1, 0); PG8_SCHED; PG8_LDA(At, 1, 0); PG8_STAGE(PG8_SA(0, 1), a2 + hstep, voffA);
            PG8_WAIT_L(8); PG8_BAR; PG8_WAIT_L(0); PG8_MMA(0, 0, At, B0); PG8_BAR; PG8_SCHED;
            PG8_LDB(B1, 1, 1); PG8_STAGE(PG8_SB(1, 0), b3, voffB);
            PG8_BAR; PG8_WAIT_L(0); PG8_MMA(0, 1, At, B1); PG8_BAR;
            PG8_LDA(At, 1, 1); PG8_STAGE(PG8_SA(1, 0), a3, voffA);
            PG8_BAR; PG8_WAIT_L(0); PG8_MMA(1, 0, At, B0); PG8_BAR; PG8_SCHED;
            PG8_STAGE(PG8_SB(1, 1), b3 + hstep, voffB);
            PG8_WAIT_V(6); PG8_BAR; PG8_MMA(1, 1, At, B1); PG8_BAR;
            }
        }
        if constexpr (ALIGN_EPI) { if (wr == 0) PG8_BAR; }
        if constexpr (!Epi::AFTER_DRAIN) { E(acc, cur, wr, wc, fr, fq); S.done(cur); }
        if (!has_next) break;
#pragma unroll
        for (int a = 0; a < 2; ++a)
#pragma unroll
            for (int b = 0; b < 2; ++b)
#pragma unroll
                for (int m = 0; m < 4; ++m)
#pragma unroll
                    for (int n = 0; n < 2; ++n) acc[a][b][m][n] = (f32x4){0.f, 0.f, 0.f, 0.f};
        cur = nxt; cA = nA; cB = nB; ++ui;
        if constexpr (ALIGN_EPI) { if (wr == 1) PG8_BAR; }
    }
    PG8_WAIT_V(0);
    if constexpr (!ALIGN_EPI) { if (wr == 0) PG8_BAR; }
    PG8_BAR;
    if constexpr (Epi::AFTER_DRAIN) { E.fused(acc, cur, wr, wc, fr, fq, lds, wid, lane); S.done(cur); }
#undef PG8_SA
#undef PG8_SB
#undef PG8_STAGE
#undef PG8_LDA
#undef PG8_LDB
#undef PG8_MMA
#undef PG8_WAIT_V
#undef PG8_WAIT_L
#undef PG8_BAR
#undef PG8_SCHED
}
}
constexpr int NWAVES = 8, NT = NWAVES * 64;
constexpr int DM = 1024, M_P = 4 * 4096, M_S = 4 * 8192, M = M_P + M_S;
constexpr int NPROJ = 6688, NPAD = 6912, KOUT = 2048;
constexpr float EPS = 1e-5f;
constexpr size_t MiB = 1u << 20;
constexpr size_t WS_CTL = 0, CTL_ZERO_BYTES = 1 * MiB;
constexpr size_t CTL_SSQ_SSD = 256 * 1024, CTL_SSQ_OUT = 512 * 1024;
constexpr size_t WS_WIN = 2 * MiB;
constexpr size_t WS_WOUT = 16 * MiB;
constexpr size_t WS_ROPE = 20 * MiB;
constexpr size_t WS_DT = 22 * MiB;
constexpr size_t WS_MIX = 32 * MiB;
constexpr size_t WS_K = 224 * MiB, WS_V = 320 * MiB, WS_ZA = 416 * MiB, WS_XS = 512 * MiB;
constexpr size_t WS_BCR = 608 * MiB;
constexpr size_t WS_FREE = 656 * MiB;
constexpr size_t WS_END = 768 * MiB;
constexpr int CW_BAR = 4096, CW_QCTR = 1024;
constexpr int RING_OFF = 0, RING_BYTES = 131072;
constexpr int LDSCTL_OFF = RING_BYTES, MISC_OFF = LDSCTL_OFF + 320;
constexpr int LDS_BYTES = 147456;
#define GAS __attribute__((address_space(1)))
#define LAS __attribute__((address_space(3)))
typedef unsigned short bf16;
typedef unsigned v4u __attribute__((ext_vector_type(4)));
typedef unsigned v2u __attribute__((ext_vector_type(2)));
typedef float f32x4 __attribute__((ext_vector_type(4)));
#define LDS_WAIT() asm volatile("s_waitcnt lgkmcnt(0)" ::: "memory")
#define VM_WAIT() asm volatile("s_waitcnt vmcnt(0)" ::: "memory")
__device__ __forceinline__ unsigned f2bf(float f) { unsigned u = __builtin_bit_cast(unsigned, f); return (u + 0x7fffu + ((u >> 16) & 1u)) >> 16; }
__device__ __forceinline__ unsigned pk2(float lo, float hi) { return f2bf(lo) | (f2bf(hi) << 16); }
__device__ __forceinline__ float bf2f(unsigned short b) { return __builtin_bit_cast(float, (unsigned)b << 16); }
__device__ __forceinline__ float bflo(unsigned w) { return __builtin_bit_cast(float, w << 16); }
__device__ __forceinline__ float bfhi(unsigned w) { return __builtin_bit_cast(float, w & 0xffff0000u); }
__device__ __forceinline__ float silu_f(float v) { return v * __builtin_amdgcn_rcpf(1.f + __builtin_amdgcn_exp2f(-1.4426950408889634f * v)); }
#define XB_TMO      128
#define XB_XCNT(j)  (256  + 64 * (j))
#define XB_XSUB(j)  (1280 + 64 * (j))
#define XB_XGEN(j)  (2304 + 64 * (j))
#define XB_TOP      3328
#define XB_TOPGEN   3392
#define XCD_BAR_WORDS 3456
#define XB_SPIN_CAP (1u << 18)

__device__ __forceinline__ unsigned xb_ld(unsigned* p)              { return __hip_atomic_load(p, __ATOMIC_RELAXED, __HIP_MEMORY_SCOPE_AGENT); }
__device__ __forceinline__ unsigned xb_add(unsigned* p, unsigned v) { return __hip_atomic_fetch_add(p, v, __ATOMIC_RELAXED, __HIP_MEMORY_SCOPE_AGENT); }
__device__ __forceinline__ unsigned xb_xcc_id() { return (unsigned)__builtin_amdgcn_s_getreg((3 << 11) | 20) & 0xFu; }
#define XB_SPIN(cond, bar) do { unsigned _sp = 0; while (cond) { __builtin_amdgcn_s_sleep(1); \
    if ((++_sp & 255u) == 0u) { if (xb_ld(&(bar)[XB_TMO])) break; if (_sp > XB_SPIN_CAP) { atomicAdd(&(bar)[XB_TMO], 1u); break; } } } } while (0)

struct XcdBarrier {
    unsigned* bar; unsigned x;
    volatile LAS unsigned* st;
};

__device__ __forceinline__ XcdBarrier xcd_barrier_post(unsigned* bar, volatile LAS unsigned* st) {
    XcdBarrier b; b.bar = bar; b.x = xb_xcc_id(); b.st = st;
    if (threadIdx.x == 0) (void)xb_add(&bar[XB_XCNT(b.x)], 1u);
    return b;
}
__device__ __forceinline__ void xcd_barrier_complete(unsigned* bar, unsigned x, unsigned& nloc, unsigned& nx) {
    const unsigned G = gridDim.x * gridDim.y * gridDim.z;
    unsigned sum, cnt, mine, sp = 0u;
    for (;;) {
        sum = 0u; cnt = 0u; mine = 0u;
#pragma unroll
        for (unsigned j = 0; j < 16; ++j) { const unsigned c = xb_ld(&bar[XB_XCNT(j)]); sum += c; cnt += (c > 0u) ? 1u : 0u; mine = (j == x) ? c : mine; }
        if (sum == G) break;
        __builtin_amdgcn_s_sleep(1);
        if ((++sp & 255u) == 0u) { if (xb_ld(&bar[XB_TMO])) break; if (sp > XB_SPIN_CAP) { atomicAdd(&bar[XB_TMO], 1u); break; } }
    }
    nloc = mine > 0u ? mine : 1u; nx = cnt > 0u ? cnt : 1u;
}

__device__ __forceinline__ void xcd_barrier(const XcdBarrier& b) {
    asm volatile("s_waitcnt vmcnt(0)" ::: "memory");
    __syncthreads();
    if (threadIdx.x == 0) {
        unsigned* bar = b.bar;
        __builtin_amdgcn_s_waitcnt(0);
        unsigned nloc = b.st[0], nx = b.st[1];
        if (nloc == 0u) { xcd_barrier_complete(bar, b.x, nloc, nx); b.st[0] = nloc; b.st[1] = nx; }
        const unsigned old = xb_add(&bar[XB_XSUB(b.x)], 1u);
        const unsigned gen = old / nloc;
        if (old + 1u == (gen + 1u) * nloc) {
            __builtin_amdgcn_fence(__ATOMIC_RELEASE, "agent");
            asm volatile("s_waitcnt vmcnt(0)" ::: "memory");
            const unsigned og = xb_add(&bar[XB_TOP], 1u);
            const unsigned tg = og / nx;
            if (og + 1u == (tg + 1u) * nx) xb_add(&bar[XB_TOPGEN], 1u);
            else XB_SPIN(xb_ld(&bar[XB_TOPGEN]) == tg, bar);
            __builtin_amdgcn_fence(__ATOMIC_ACQUIRE, "agent");
            xb_add(&bar[XB_XGEN(b.x)], 1u);
            asm volatile("s_waitcnt vmcnt(0)" ::: "memory");
        } else {
            XB_SPIN(xb_ld(&bar[XB_XGEN(b.x)]) == gen, bar);
            __builtin_amdgcn_fence(__ATOMIC_ACQUIRE, "agent");
            asm volatile("s_waitcnt vmcnt(0)" ::: "memory");
        }
    }
    __syncthreads();
}
struct Args { const float* in[14]; float* out; unsigned char* ws; int ph_lo, ph_hi; };
struct Frame {
    LAS unsigned char* lds; int tid, lane, wave, G, bid;
    const float *xp, *xsm, *w_in, *conv_w, *conv_b, *dtb_f, *dtb_b, *alog_f, *alog_b, *dskip, *norm_ssd, *norm_in, *w_out, *norm_f;
    float* out; unsigned char* ws;
    bf16 *WIN, *WOUT, *MIX, *KB, *VB, *ZA, *XS, *BCR, *XN, *XC, *YF; float *ROPE, *DT, *SSQ_SSD, *SSQ_OUT;
};
__device__ __forceinline__ float wave_sum(float v) {
#pragma unroll
    for (int o = 1; o < 64; o <<= 1) v += __shfl_xor(v, o);
    return v;
}
__device__ __forceinline__ void row_info(int row, int& seq0, int& pos, int& S) {
    if (row < M_P) { S = 4096; pos = row & 4095; seq0 = row & ~4095; } else { const int r = row - M_P; S = 8192; pos = r & 8191; seq0 = M_P + (r & ~8191); }
}
__device__ __forceinline__ int win_dst_row(int s) { if (s < 2048) { const int d = s & 63; return (s & ~63) + (d < 32 ? 2 * d : 2 * (d - 32) + 1); } return s; }
template <bool PERMQ>
__device__ __forceinline__ void transpose_item(const float* W, int K, int N, bf16* WT, const float* kscale, int nscale, LAS float* scr, int item, int lane) {
    const int nblk = N / 32, kb = item / nblk, nb = item % nblk, k0 = 64 * kb, n0 = 32 * nb;
#pragma unroll 8
    for (int i = 0; i < 32; ++i) { const int kk = 2 * i + (lane >> 5); const float sc = (k0 + kk < nscale) ? kscale[k0 + kk] : 1.f;
        scr[kk * 33 + (lane & 31)] = W[(size_t)(k0 + kk) * N + n0 + (lane & 31)] * sc; }
    LDS_WAIT(); asm volatile("" ::: "memory");
    const int c = lane & 7;
#pragma unroll
    for (int j = 0; j < 4; ++j) { const int n = (lane >> 3) + 8 * j; const LAS float* s = scr + (8 * c) * 33 + n;
        v4u o; o.x = pk2(s[0 * 33], s[1 * 33]); o.y = pk2(s[2 * 33], s[3 * 33]); o.z = pk2(s[4 * 33], s[5 * 33]); o.w = pk2(s[6 * 33], s[7 * 33]);
        const int dst = PERMQ ? win_dst_row(n0 + n) : (n0 + n);
        *(GAS v4u*)(WT + (size_t)dst * K + k0 + 8 * c) = o; }
    LDS_WAIT(); asm volatile("" ::: "memory");
}
__device__ __forceinline__ void p0_prologue(Frame& F) {
    LAS float* scr = (LAS float*)(F.lds + RING_OFF + F.wave * 16384);
    const int gw = F.bid * NWAVES + F.wave, NGW = F.G * NWAVES;
    constexpr int I_IN = (DM / 64) * (NPROJ / 32), I_OUT = (KOUT / 64) * (DM / 32);
    for (int it = gw; it < I_IN + I_OUT; it += NGW) {
        if (it < I_IN) transpose_item<true>(F.w_in, DM, NPROJ, F.WIN, F.norm_in, DM, scr, it, F.lane);
        else transpose_item<false>(F.w_out, KOUT, DM, F.WOUT, F.norm_ssd, 1024, scr, it - I_IN, F.lane);
    }
    {
        const int gt = F.bid * NT + F.tid, NGT = F.G * NT; constexpr int NV = (NPAD - NPROJ) * DM / 8;
        GAS v4u* z = (GAS v4u*)(F.WIN + (size_t)NPROJ * DM);
        for (int i = gt; i < NV; i += NGT) z[i] = (v4u){0u, 0u, 0u, 0u};
        for (int i = gt; i < 8192 * 32; i += NGT) {
            const int pos = i >> 5, j = i & 31; double inv = 1.0; for (int q = 0; q < j; ++q) inv *= 0.7498942093324558273;
            const double ang = (double)pos * inv; const double k = rint(ang * 0.15915494309189533577); double r = ang - k * 6.283185307179586476925;
            const double qd = rint(r * 0.63661977236758134308); const double t = r - qd * 1.57079632679489661923; const double t2 = t * t;
            double sn = t * (1.0 + t2 * (-1.0 / 6 + t2 * (1.0 / 120 + t2 * (-1.0 / 5040 + t2 * (1.0 / 362880 + t2 * (-1.0 / 39916800 + t2 * (1.0 / 6227020800.0)))))));
            double cs = 1.0 + t2 * (-0.5 + t2 * (1.0 / 24 + t2 * (-1.0 / 720 + t2 * (1.0 / 40320 + t2 * (-1.0 / 3628800 + t2 * (1.0 / 479001600.0 + t2 * (-1.0 / 87178291200.0)))))));
            const int qi = ((int)qd) & 3; double c, s;
            if (qi == 0) { c = cs; s = sn; } else if (qi == 1) { c = -sn; s = cs; } else if (qi == 2) { c = -cs; s = -sn; } else { c = sn; s = -cs; }
            F.ROPE[2 * i] = (float)c; F.ROPE[2 * i + 1] = (float)s;
        }
    }
    for (int m = gw; m < M; m += NGW) {
        const float* xrow = m < M_P ? F.xp + (size_t)m * DM : F.xsm + (size_t)(m - M_P) * DM;
        const GAS f32x4* xr = (const GAS f32x4*)xrow + F.lane; f32x4 v[4]; float s = 0.f;
#pragma unroll
        for (int j = 0; j < 4; ++j) { v[j] = xr[64 * j]; s += (v[j].x * v[j].x + v[j].y * v[j].y) + (v[j].z * v[j].z + v[j].w * v[j].w); }
        const float rs = 1.f / sqrtf(wave_sum(s) * (1.f / DM) + EPS);
        GAS unsigned long long* o8 = (GAS unsigned long long*)(F.XN + (size_t)m * DM) + F.lane;
#pragma unroll
        for (int j = 0; j < 4; ++j) o8[64 * j] = (unsigned long long)pk2(v[j].x * rs, v[j].y * rs) | ((unsigned long long)pk2(v[j].z * rs, v[j].w * rs) << 32);
    }
}
__device__ __forceinline__ void nv_conv(Frame& F) {
    const int gt = F.bid * NT + F.tid, NGT = F.G * NT;
    for (int i = gt; i < M * 192; i += NGT) {
        const int row = i / 192, c8 = (i % 192) * 8; int seq0, pos, S; row_info(row, seq0, pos, S);
        float a[8];
#pragma unroll
        for (int e = 0; e < 8; ++e) a[e] = F.conv_b[c8 + e];
#pragma unroll
        for (int j = 0; j < 5; ++j) { const int p2 = pos + j - 2; if (p2 < 0 || p2 >= S) continue; const int r2 = seq0 + p2;
            const v4u w = c8 < 1024 ? *(const v4u*)(F.XS + (size_t)r2 * 1024 + c8) : *(const v4u*)(F.BCR + (size_t)r2 * 512 + (c8 - 1024));
            const float* cw = F.conv_w + j * 1536 + c8;
            a[0] += cw[0] * bflo(w.x); a[1] += cw[1] * bfhi(w.x); a[2] += cw[2] * bflo(w.y); a[3] += cw[3] * bfhi(w.y);
            a[4] += cw[4] * bflo(w.z); a[5] += cw[5] * bfhi(w.z); a[6] += cw[6] * bflo(w.w); a[7] += cw[7] * bfhi(w.w); }
#pragma unroll
        for (int e = 0; e < 8; ++e) a[e] = silu_f(a[e]);
        v4u o; o.x = pk2(a[0], a[1]); o.y = pk2(a[2], a[3]); o.z = pk2(a[4], a[5]); o.w = pk2(a[6], a[7]);
        *(v4u*)(F.XC + (size_t)row * 1536 + c8) = o;
    }
}
__device__ __forceinline__ void nv_ssd_chain(Frame& F, int item, int dir) {
    const int b = item >> 4, head = item & 15, g = head >> 3;
    const int S = b < 4 ? 4096 : 8192, seq0 = b < 4 ? b * 4096 : M_P + (b - 4) * 8192;
    LAS float* Bs = (LAS float*)(F.lds); LAS float* Cs = Bs + 32 * 128; LAS float* xs = Cs + 32 * 128; LAS float* dtv = xs + 32 * 64; LAS float* dAv = dtv + 32; LAS float* yp = dAv + 32;
    const int p = F.tid & 63, ng = F.wave;
    const float A = -__expf(dir ? F.alog_b[head] : F.alog_f[head]); const float dtb = dir ? F.dtb_b[head] : F.dtb_f[head]; const float Dh = F.dskip[head];
    float St[16];
#pragma unroll
    for (int j = 0; j < 16; ++j) St[j] = 0.f;
    for (int blk = 0; blk < S / 32; ++blk) {
        __syncthreads();
        for (int e = F.tid; e < 32 * 128; e += NT) { const int i = e >> 7, n = e & 127; const int t = dir ? S - 1 - (blk * 32 + i) : blk * 32 + i;
            const bf16* r = F.XC + (size_t)(seq0 + t) * 1536; Bs[e] = bf2f(r[1024 + g * 128 + n]); Cs[e] = bf2f(r[1280 + g * 128 + n]); }
        for (int e = F.tid; e < 32 * 64; e += NT) { const int i = e >> 6, pp = e & 63; const int t = dir ? S - 1 - (blk * 32 + i) : blk * 32 + i;
            xs[e] = bf2f(F.XC[(size_t)(seq0 + t) * 1536 + head * 64 + pp]); }
        if (F.tid < 32) { const int t = dir ? S - 1 - (blk * 32 + F.tid) : blk * 32 + F.tid; const float raw = F.DT[(size_t)(seq0 + t) * 32 + dir * 16 + head] + dtb;
            const float dt = raw > 20.f ? raw : log1pf(__expf(raw)); dtv[F.tid] = dt; dAv[F.tid] = __expf(dt * A); }
        __syncthreads();
        for (int i = 0; i < 32; ++i) {
            const float xdt = xs[i * 64 + p] * dtv[i], da = dAv[i]; float y = 0.f;
#pragma unroll
            for (int j = 0; j < 16; ++j) { const int n = ng * 16 + j; St[j] = St[j] * da + xdt * Bs[i * 128 + n]; y += Cs[i * 128 + n] * St[j]; }
            yp[(i * 8 + ng) * 64 + p] = y;
        }
        __syncthreads();
        for (int e = F.tid; e < 2048; e += NT) { const int i = e >> 6, pp = e & 63; float y = 0.f;
#pragma unroll
            for (int q = 0; q < 8; ++q) y += yp[(i * 8 + q) * 64 + pp];
            const int t = dir ? S - 1 - (blk * 32 + i) : blk * 32 + i; const size_t row = (size_t)(seq0 + t);
            if (dir == 0) F.YF[row * 1024 + head * 64 + pp] = (bf16)f2bf(y);
            else { const float tot = y + bf2f(F.YF[row * 1024 + head * 64 + pp]) + Dh * xs[i * 64 + pp];
                bf16* zp = F.MIX + row * 2048 + head * 64 + pp; const float val = tot * silu_f(bf2f(*zp)); *zp = (bf16)f2bf(val);
                const float sq = wave_sum(val * val); if (F.lane == 0) atomicAdd(F.SSQ_SSD + row, sq); }
        }
    }
}
__device__ __forceinline__ void nv_attn_unit(Frame& F, int unit) {
    const int idx = unit * NT + F.tid; const int head = idx / M, row = idx % M; int seq0, pos, S; row_info(row, seq0, pos, S);
    float q[64], o[64];
    { const v4u* qp = (const v4u*)(F.MIX + (size_t)row * 2048 + 1024 + head * 64);
#pragma unroll
      for (int c = 0; c < 8; ++c) { const v4u w = qp[c]; q[8 * c] = bflo(w.x); q[8 * c + 1] = bfhi(w.x); q[8 * c + 2] = bflo(w.y); q[8 * c + 3] = bfhi(w.y); q[8 * c + 4] = bflo(w.z); q[8 * c + 5] = bfhi(w.z); q[8 * c + 6] = bflo(w.w); q[8 * c + 7] = bfhi(w.w); } }
#pragma unroll
    for (int d = 0; d < 64; ++d) o[d] = 0.f;
    float mx = -INFINITY, l = 0.f;
    for (int pat = 0; pat < 3; ++pat) { const int dil = pat == 0 ? 1 : (pat == 1 ? 4 : 16);
        for (int mm = -64; mm <= 64; ++mm) { const int p2 = pos + mm * dil; if (p2 < 0 || p2 >= S) continue; const size_t r2 = (size_t)(seq0 + p2);
            const v4u* kp = (const v4u*)(F.KB + r2 * 1024 + head * 64); float s = 0.f;
#pragma unroll
            for (int c = 0; c < 8; ++c) { const v4u w = kp[c]; s += q[8 * c] * bflo(w.x) + q[8 * c + 1] * bfhi(w.x) + q[8 * c + 2] * bflo(w.y) + q[8 * c + 3] * bfhi(w.y) + q[8 * c + 4] * bflo(w.z) + q[8 * c + 5] * bfhi(w.z) + q[8 * c + 6] * bflo(w.w) + q[8 * c + 7] * bfhi(w.w); }
            if (s > mx) { const float f = exp2f(mx - s); l *= f;
#pragma unroll
                for (int d = 0; d < 64; ++d) o[d] *= f;
                mx = s; }
            const float pw = exp2f(s - mx); l += pw;
            const v4u* vp = (const v4u*)(F.VB + r2 * 1024 + head * 64);
#pragma unroll
            for (int c = 0; c < 8; ++c) { const v4u w = vp[c]; o[8 * c] += pw * bflo(w.x); o[8 * c + 1] += pw * bfhi(w.x); o[8 * c + 2] += pw * bflo(w.y); o[8 * c + 3] += pw * bfhi(w.y); o[8 * c + 4] += pw * bflo(w.z); o[8 * c + 5] += pw * bfhi(w.z); o[8 * c + 6] += pw * bflo(w.w); o[8 * c + 7] += pw * bfhi(w.w); }
        } }
    const float il = 1.f / l; const v4u* zp = (const v4u*)(F.ZA + (size_t)row * 1024 + head * 64); v4u* op = (v4u*)(F.MIX + (size_t)row * 2048 + 1024 + head * 64);
#pragma unroll
    for (int c = 0; c < 8; ++c) { const v4u z = zp[c]; v4u w;
        w.x = pk2(o[8 * c] * il * silu_f(bflo(z.x)), o[8 * c + 1] * il * silu_f(bfhi(z.x))); w.y = pk2(o[8 * c + 2] * il * silu_f(bflo(z.y)), o[8 * c + 3] * il * silu_f(bfhi(z.y)));
        w.z = pk2(o[8 * c + 4] * il * silu_f(bflo(z.z)), o[8 * c + 5] * il * silu_f(bfhi(z.z))); w.w = pk2(o[8 * c + 6] * il * silu_f(bflo(z.w)), o[8 * c + 7] * il * silu_f(bfhi(z.w)));
        op[c] = w; }
}
__device__ __forceinline__ void nv_ssd_norm(Frame& F) {
    const int gt = F.bid * NT + F.tid, NGT = F.G * NT;
    for (int i = gt; i < M * 128; i += NGT) { const int row = i >> 7, c8 = (i & 127) * 8; const float rs = 1.f / sqrtf(F.SSQ_SSD[row] * (1.f / 1024.f) + EPS);
        v4u* p = (v4u*)(F.MIX + (size_t)row * 2048 + c8); v4u w = *p;
        w.x = pk2(bflo(w.x) * rs, bfhi(w.x) * rs); w.y = pk2(bflo(w.y) * rs, bfhi(w.y) * rs); w.z = pk2(bflo(w.z) * rs, bfhi(w.z) * rs); w.w = pk2(bflo(w.w) * rs, bfhi(w.w) * rs); *p = w; }
}
__device__ __forceinline__ void final_norm(Frame& F) {
    const int gt = F.bid * NT + F.tid, NGT = F.G * NT;
    for (int i = gt; i < M * 256; i += NGT) { const int row = i >> 8, c4 = (i & 255) * 4; const float rs = 1.f / sqrtf(F.SSQ_OUT[row] * (1.f / 1024.f) + EPS);
        f32x4* p = (f32x4*)(F.out + (size_t)row * 1024 + c4); const f32x4 g = *(const f32x4*)(F.norm_f + c4); *p = *p * rs * g; }
}
typedef short bf16x8 __attribute__((ext_vector_type(8)));
typedef short s16x4 __attribute__((ext_vector_type(4)));
typedef short v4i16_t __attribute__((ext_vector_type(4)));
typedef float f32x16 __attribute__((ext_vector_type(16)));
typedef float f32x2_t __attribute__((ext_vector_type(2))); typedef __bf16 bf16x2_t __attribute__((ext_vector_type(2)));
__device__ __forceinline__ unsigned cvtpk(float lo, float hi) { f32x2_t v = {lo, hi}; bf16x2_t b = __builtin_convertvector(v, bf16x2_t); return __builtin_bit_cast(unsigned, b); }
__device__ __forceinline__ s16x4 vtr(LAS const unsigned char* p) { return __builtin_bit_cast(s16x4, __builtin_amdgcn_ds_read_tr16_b64_v4i16((LAS v4i16_t*)p)); }
#define MFMA32(a, b, c) __builtin_amdgcn_mfma_f32_32x32x16_bf16((a), (b), (c), 0, 0, 0)
constexpr int AT_KROW = 144;
constexpr int AT_UNITS = 3072;
struct AtUnit { int head, S, seq0, rho, blk, lsub, kstart; };
template <int DIL> __device__ __forceinline__ AtUnit at_decode(int u) {
    AtUnit a; a.head = u & 15; const int tb = u >> 4; int within;
    if (tb < 64) { a.S = 4096; a.seq0 = (tb >> 4) * 4096; within = tb & 15; } else { const int t2 = tb - 64; a.S = 8192; a.seq0 = M_P + (t2 >> 5) * 8192; within = t2 & 31; }
    a.rho = within % DIL; a.blk = within / DIL; a.lsub = a.S / DIL; a.kstart = a.blk * 256 - 64; return a;
}
template <int DIL> __device__ __forceinline__ void at_stage_load(Frame& F, const AtUnit& a, v4u (&kv)[6], v4u (&vv)[6]) {
#pragma unroll
    for (int it = 0; it < 6; ++it) { const int e = F.tid + it * NT, i = e >> 3, c = e & 7; int ku = a.kstart + i; ku = ku < 0 ? 0 : (ku >= a.lsub ? a.lsub - 1 : ku);
        const size_t off = (size_t)(a.seq0 + ku * DIL + a.rho) * 1024 + a.head * 64 + c * 8; kv[it] = *(const v4u*)(F.KB + off); vv[it] = *(const v4u*)(F.VB + off); }
}
__device__ __forceinline__ void at_stage_write(Frame& F, const AtUnit& a, const v4u (&kv)[6], const v4u (&vv)[6]) {
    LAS unsigned char* Ks = F.lds; LAS unsigned char* Vs = F.lds + 384 * AT_KROW;
#pragma unroll
    for (int it = 0; it < 6; ++it) { const int e = F.tid + it * NT, i = e >> 3, c = e & 7, ku = a.kstart + i; const bool ok = ku >= 0 && ku < a.lsub; const v4u z = {0u, 0u, 0u, 0u};
        *(LAS v4u*)(Ks + i * AT_KROW + c * 16) = ok ? kv[it] : z; *(LAS v4u*)(Vs + i * AT_KROW + c * 16) = ok ? vv[it] : z; }
}
template <int DIL, int PASS>
__device__ __forceinline__ void attn_compute(Frame& F, const AtUnit& a, bf16* OST, float* LST) {
    LAS unsigned char* Ks = F.lds; LAS unsigned char* Vs = F.lds + 384 * AT_KROW;
    const int head = a.head, seq0 = a.seq0, rho = a.rho, blk = a.blk, lsub = a.lsub, kstart = a.kstart;
    const int w = F.wave, lane = F.lane, c = lane & 31, h = lane >> 5;
    const size_t rowq = (size_t)(seq0 + (blk * 256 + 32 * w + c) * DIL + rho);
    bf16x8 qf[4];
#pragma unroll
    for (int s = 0; s < 4; ++s) qf[s] = *(const bf16x8*)(F.MIX + rowq * 2048 + 1024 + head * 64 + 16 * s + 8 * h);
    bf16* st = OST + rowq * 1024 + head * 64 + 4 * h; v2u sv[8]; float lse0 = 0.f; v2u zv[8];
    if (PASS != 0) { lse0 = LST[rowq * 16 + head];
#pragma unroll
        for (int q = 0; q < 8; ++q) sv[q] = *(const v2u*)(st + (q >> 2) * 32 + 8 * (q & 3)); }
    if (PASS == 2) { const bf16* zp = F.ZA + rowq * 1024 + head * 64 + 4 * h;
#pragma unroll
        for (int q = 0; q < 8; ++q) zv[q] = *(const v2u*)(zp + (q >> 2) * 32 + 8 * (q & 3)); }
    f32x16 sc[5];
#pragma unroll
    for (int kbl = 0; kbl < 5; ++kbl) {
        f32x16 acc;
#pragma unroll
        for (int i = 0; i < 16; ++i) acc[i] = 0.f;
        LAS const unsigned char* kp = Ks + (32 * (w + kbl) + c) * AT_KROW + 16 * h;
#pragma unroll
        for (int s = 0; s < 4; ++s) { const bf16x8 kf = *(LAS const bf16x8*)(kp + 32 * s); acc = MFMA32(kf, qf[s], acc); }
        sc[kbl] = acc;
    }
#pragma unroll
    for (int i = 0; i < 16; ++i) { const int ri = (i & 3) + 8 * (i >> 2) + 4 * h;
        sc[0][i] = ri >= c ? sc[0][i] : -INFINITY; sc[4][i] = ri <= c ? sc[4][i] : -INFINITY; }
    if (blk == 0 || (blk + 1) * 256 == lsub) {
#pragma unroll
        for (int kbl = 0; kbl < 5; ++kbl)
#pragma unroll
            for (int i = 0; i < 16; ++i) { const int ku = kstart + 32 * (w + kbl) + (i & 3) + 8 * (i >> 2) + 4 * h; sc[kbl][i] = (ku >= 0 && ku < lsub) ? sc[kbl][i] : -INFINITY; }
    }
    float mx = -INFINITY;
#pragma unroll
    for (int kbl = 0; kbl < 5; ++kbl)
#pragma unroll
        for (int i = 0; i < 16; ++i) mx = fmaxf(mx, sc[kbl][i]);
    mx = fmaxf(mx, __shfl_xor(mx, 32));
    float l = 0.f;
#pragma unroll
    for (int kbl = 0; kbl < 5; ++kbl)
#pragma unroll
        for (int i = 0; i < 16; ++i) { const float p = __builtin_amdgcn_exp2f(sc[kbl][i] - mx); sc[kbl][i] = p; l += p; }
    l += __shfl_xor(l, 32);
    f32x16 o[2];
#pragma unroll
    for (int i = 0; i < 16; ++i) { o[0][i] = 0.f; o[1][i] = 0.f; }
    LAS const unsigned char* vb = Vs + (4 * h + ((lane & 15) >> 2)) * AT_KROW + (16 * ((lane >> 4) & 1) + 4 * (lane & 3)) * 2;
#pragma unroll
    for (int kbl = 0; kbl < 5; ++kbl)
#pragma unroll
        for (int s2 = 0; s2 < 2; ++s2) {
            v4u pw; pw.x = cvtpk(sc[kbl][8 * s2], sc[kbl][8 * s2 + 1]); pw.y = cvtpk(sc[kbl][8 * s2 + 2], sc[kbl][8 * s2 + 3]);
            pw.z = cvtpk(sc[kbl][8 * s2 + 4], sc[kbl][8 * s2 + 5]); pw.w = cvtpk(sc[kbl][8 * s2 + 6], sc[kbl][8 * s2 + 7]);
            const bf16x8 pf = __builtin_bit_cast(bf16x8, pw);
            LAS const unsigned char* vk = vb + (32 * (w + kbl) + 16 * s2) * AT_KROW;
#pragma unroll
            for (int dt = 0; dt < 2; ++dt) {
                const s16x4 lo = vtr(vk + dt * 64), hi = vtr(vk + 8 * AT_KROW + dt * 64);
                const bf16x8 vf = __builtin_shufflevector(lo, hi, 0, 1, 2, 3, 4, 5, 6, 7);
                o[dt] = MFMA32(vf, pf, o[dt]);
            }
        }
    const float il = 1.f / l; float lse = mx + __builtin_amdgcn_logf(l);
#pragma unroll
    for (int i = 0; i < 16; ++i) { o[0][i] *= il; o[1][i] *= il; }
    if (PASS != 0) {
        const float ln = fmaxf(lse, lse0) + __builtin_amdgcn_logf(1.f + __builtin_amdgcn_exp2f(-fabsf(lse - lse0)));
        const float wa = __builtin_amdgcn_exp2f(lse0 - ln), wb = __builtin_amdgcn_exp2f(lse - ln);
#pragma unroll
        for (int dt = 0; dt < 2; ++dt)
#pragma unroll
            for (int g = 0; g < 4; ++g) { const v2u pv = sv[dt * 4 + g];
                o[dt][4 * g] = o[dt][4 * g] * wb + bflo(pv.x) * wa; o[dt][4 * g + 1] = o[dt][4 * g + 1] * wb + bfhi(pv.x) * wa;
                o[dt][4 * g + 2] = o[dt][4 * g + 2] * wb + bflo(pv.y) * wa; o[dt][4 * g + 3] = o[dt][4 * g + 3] * wb + bfhi(pv.y) * wa; }
        lse = ln;
    }
    if (PASS != 2) {
#pragma unroll
        for (int dt = 0; dt < 2; ++dt)
#pragma unroll
            for (int g = 0; g < 4; ++g) { v2u pv; pv.x = cvtpk(o[dt][4 * g], o[dt][4 * g + 1]); pv.y = cvtpk(o[dt][4 * g + 2], o[dt][4 * g + 3]); *(v2u*)(st + dt * 32 + 8 * g) = pv; }
        if (h == 0) LST[rowq * 16 + head] = lse;
    } else {
        bf16* yp = F.MIX + rowq * 2048 + 1024 + head * 64 + 4 * h;
#pragma unroll
        for (int dt = 0; dt < 2; ++dt)
#pragma unroll
            for (int g = 0; g < 4; ++g) { const v2u z = zv[dt * 4 + g]; v2u pv;
                pv.x = cvtpk(o[dt][4 * g] * silu_f(bflo(z.x)), o[dt][4 * g + 1] * silu_f(bfhi(z.x))); pv.y = cvtpk(o[dt][4 * g + 2] * silu_f(bflo(z.y)), o[dt][4 * g + 3] * silu_f(bfhi(z.y)));
                *(v2u*)(yp + dt * 32 + 8 * g) = pv; }
    }
}
template <int DIL, int PASS, bool DYN>
__device__ __forceinline__ void attn_phase(Frame& F, bf16* OST, float* LST, unsigned* ctr) {
    volatile LAS unsigned* shu = (volatile LAS unsigned*)(F.lds + MISC_OFF) + 16;
    int u;
    if (DYN) { __syncthreads(); if (F.tid == 0) *shu = atomicAdd(ctr, 1u); __syncthreads(); u = (int)*shu; __syncthreads(); } else u = F.bid;
    v4u kv[6], vv[6]; AtUnit a = at_decode<DIL>(u < AT_UNITS ? u : 0);
    if (u < AT_UNITS) at_stage_load<DIL>(F, a, kv, vv);
    while (u < AT_UNITS) {
        if (DYN && F.tid == 0) *shu = atomicAdd(ctr, 1u);
        __syncthreads();
        at_stage_write(F, a, kv, vv);
        const int un = DYN ? (int)*shu : u + F.G;
        __syncthreads();
        const AtUnit an = at_decode<DIL>(un < AT_UNITS ? un : 0);
        if (un < AT_UNITS) at_stage_load<DIL>(F, an, kv, vv);
        attn_compute<DIL, PASS>(F, a, OST, LST);
        u = un; a = an;
    }
}
constexpr int SP_ROW = 272;
__device__ __forceinline__ void ssd_pre_item(Frame& F, int item, bf16* CC, bf16* BT, bf16* CB, float* DTC, float* ACLC) {
    const int gc = item >> 1, g = item & 1, row0 = gc * 128; int seq0, pos0, S; row_info(row0, seq0, pos0, S);
    LAS unsigned char* Bt = F.lds; LAS unsigned char* Ct = F.lds + 128 * SP_ROW;
    __syncthreads();
    for (int e = F.tid; e < 128 * 32; e += NT) {
        const int tok = e >> 5, cg = e & 31, isC = cg >> 4, n0 = (cg & 15) * 8, chan = isC * 256 + g * 128 + n0;
        float a[8]; const float* cb = F.conv_b + 1024 + chan;
#pragma unroll
        for (int q = 0; q < 8; ++q) a[q] = cb[q];
#pragma unroll
        for (int j = 0; j < 5; ++j) { const int p2 = pos0 + tok + j - 2; if (p2 < 0 || p2 >= S) continue;
            const v4u w = *(const v4u*)(F.BCR + (size_t)(seq0 + p2) * 512 + chan); const float* cw = F.conv_w + j * 1536 + 1024 + chan;
            a[0] += cw[0] * bflo(w.x); a[1] += cw[1] * bfhi(w.x); a[2] += cw[2] * bflo(w.y); a[3] += cw[3] * bfhi(w.y);
            a[4] += cw[4] * bflo(w.z); a[5] += cw[5] * bfhi(w.z); a[6] += cw[6] * bflo(w.w); a[7] += cw[7] * bfhi(w.w); }
        v4u o; o.x = pk2(silu_f(a[0]), silu_f(a[1])); o.y = pk2(silu_f(a[2]), silu_f(a[3])); o.z = pk2(silu_f(a[4]), silu_f(a[5])); o.w = pk2(silu_f(a[6]), silu_f(a[7]));
        *(LAS v4u*)((isC ? Ct : Bt) + tok * SP_ROW + n0 * 2) = o;
        if (isC) *(v4u*)(CC + (size_t)(gc * 2 + g) * 16384 + ((((tok >> 5) * 8 + (n0 >> 4)) * 64 + (tok & 31) + 32 * ((n0 >> 3) & 1)) * 8)) = o;
    }
    __syncthreads();
    const int w = F.wave, lane = F.lane, c = lane & 31, h = lane >> 5; const size_t tb = (size_t)(gc * 2 + g) * 128 * 128;
#pragma unroll
    for (int tt = 0; tt < 2; ++tt) {
        const int t = 2 * w + tt, sb = t >> 2, lb = t & 3; f32x16 acc;
#pragma unroll
        for (int i = 0; i < 16; ++i) acc[i] = 0.f;
#pragma unroll
        for (int st = 0; st < 8; ++st) { const bf16x8 a = *(LAS const bf16x8*)(Bt + (32 * sb + c) * SP_ROW + (16 * st + 8 * h) * 2);
            const bf16x8 b = *(LAS const bf16x8*)(Ct + (32 * lb + c) * SP_ROW + (16 * st + 8 * h) * 2); acc = MFMA32(a, b, acc); }
#pragma unroll
        for (int gq = 0; gq < 4; ++gq) { v2u pv; pv.x = cvtpk(acc[4 * gq], acc[4 * gq + 1]); pv.y = cvtpk(acc[4 * gq + 2], acc[4 * gq + 3]);
            *(v2u*)(CB + tb + (((lb * 8 + sb * 2 + (gq >> 1)) * 64 + c + 32 * (gq & 1)) * 8 + 4 * h)) = pv; }
    }
    if (g == 0) {
        for (int combo = w; combo < 32; combo += NWAVES) { const int dir = combo >> 4, head = combo & 15;
            const float A2 = -__expf(dir ? F.alog_b[head] : F.alog_f[head]) * 1.4426950408889634f, dtb = dir ? F.dtb_b[head] : F.dtb_f[head];
            float dt[2], v[2];
#pragma unroll
            for (int q = 0; q < 2; ++q) { const float raw = F.DT[(size_t)(row0 + 64 * q + lane) * 32 + combo] + dtb; dt[q] = raw > 20.f ? raw : log1pf(__expf(raw)); v[q] = dt[q] * A2; }
            if (dir == 0) {
#pragma unroll
                for (int q = 0; q < 2; ++q)
#pragma unroll
                    for (int off = 1; off < 64; off <<= 1) { const float t = __shfl_up(v[q], off); if (lane >= off) v[q] += t; }
                v[1] += __shfl(v[0], 63);
            } else {
#pragma unroll
                for (int q = 0; q < 2; ++q)
#pragma unroll
                    for (int off = 1; off < 64; off <<= 1) { const float t = __shfl_down(v[q], off); if (lane + off < 64) v[q] += t; }
                v[0] += __shfl(v[1], 0);
            }
            float* d0 = DTC + (size_t)(gc * 32 + combo) * 128; float* a0 = ACLC + (size_t)(gc * 32 + combo) * 128;
            d0[lane] = dt[0]; d0[64 + lane] = dt[1]; a0[lane] = v[0]; a0[64 + lane] = v[1]; }
    }
    {
        const int n = F.tid & 127, sq = F.tid >> 7;
#pragma unroll
        for (int q = 0; q < 4; ++q) { unsigned v[8];
#pragma unroll
            for (int i = 0; i < 8; ++i) v[i] = *(LAS const unsigned short*)(Bt + (32 * sq + 8 * q + i) * SP_ROW + n * 2);
            v4u o; o.x = v[0] | (v[1] << 16); o.y = v[2] | (v[3] << 16); o.z = v[4] | (v[5] << 16); o.w = v[6] | (v[7] << 16);
            const int s0 = 32 * sq + 8 * q; *(v4u*)(BT + tb + ((((n >> 5) * 8 + (s0 >> 4)) * 64 + (n & 31) + 32 * ((s0 >> 3) & 1)) * 8)) = o; }
    }
}
constexpr int SC_DIR = 45056, SC_XC = 0, SC_XDT = 8192, SC_XW = 16384, SC_SB = 24576, SC_ACL = 32768, SC_DTV = 33792, SC_CW = 34880, SC_RAW = 35648;
#define SCHED_FENCE() __builtin_amdgcn_sched_barrier(0)
__device__ __forceinline__ void ssd_chain_item(Frame& F, int item, const bf16* CC, const bf16* BT, const bf16* CB, const float* DTC, const float* ACLC, bf16* PART) {
    const int xcd = item & 7, slot = item >> 3, set = ((slot >> 4) << 3) + xcd, b = set >> 1, g = set & 1, jj = slot & 15, head = g * 8 + (jj >> 1), ph = jj & 1;
    const int S = b < 4 ? 4096 : 8192, seq0 = b < 4 ? b * 4096 : M_P + (b - 4) * 8192, NC = S / 128;
    const int dir = F.wave >> 2, wq = F.wave & 3, lane = F.lane, c = lane & 31, h = lane >> 5, tq = F.tid & 255;
    LAS unsigned char* L = F.lds + dir * SC_DIR;
    const float Dh = F.dskip[head];
    const int chb = head * 64 + ph * 32, combo = dir * 16 + head;
    __syncthreads();
    f32x16 accS;
#pragma unroll
    for (int i = 0; i < 16; ++i) accS[i] = 0.f;
    const int vt_off = ((lane & 15) >> 2) * 64 + (16 * ((lane >> 4) & 1) + 4 * (lane & 3)) * 2 + 8 * h * 64;
    const int lrow = 32 * wq + c, cp = tq & 15, tg = tq >> 4;
    for (int e = tq; e < 192; e += 256) { const int j = e >> 5, p = e & 31; ((LAS float*)(L + SC_CW))[e] = j < 5 ? F.conv_w[j * 1536 + chb + p] : F.conv_b[chb + p]; }
    bf16x8 Cf[8], Bf[8], Gf[4][2]; v4u rawp[3]; float av;
    const unsigned voF = (unsigned)(wq * 8192 + lane * 16), voA = (unsigned)((tq < 128 ? 0 : 2097152) + (tq & 127)) * 4u;
    const int rawe1 = tq + 256, rawe2 = (tq + 512) < 528 ? (tq + 512) : 527;
#define LOAD_CF(ch) do { const char* b_ = (const char*)CC + (size_t)(((seq0 >> 7) + (ch)) * 2 + g) * 32768; _Pragma("unroll") for (int st = 0; st < 8; ++st) Cf[st] = *(const bf16x8*)(b_ + voF + st * 1024); } while (0)
#define LOAD_BF(ch) do { const char* b_ = (const char*)BT + (size_t)(((seq0 >> 7) + (ch)) * 2 + g) * 32768; _Pragma("unroll") for (int st = 0; st < 8; ++st) Bf[st] = *(const bf16x8*)(b_ + voF + st * 1024); } while (0)
#define LOAD_GF(ch) do { const char* b_ = (const char*)CB + (size_t)(((seq0 >> 7) + (ch)) * 2 + g) * 32768; _Pragma("unroll") for (int sb = 0; sb < 4; ++sb) \
        _Pragma("unroll") for (int st = 0; st < 2; ++st) Gf[sb][st] = *(const bf16x8*)(b_ + voF + (sb * 2 + st) * 1024); } while (0)
#define RAW_OFF(e_, ch) ({ int p2_ = (ch) * 128 + ((e_) >> 2) - 2; p2_ = p2_ < 0 ? 0 : (p2_ >= S ? S - 1 : p2_); (unsigned)(p2_ * 1024 + chb + ((e_) & 3) * 8) * 2u; })
#define LOAD_XR(ch) do { const char* b_ = (const char*)F.XS + (size_t)seq0 * 2048; rawp[0] = *(const v4u*)(b_ + RAW_OFF(tq, ch)); rawp[1] = *(const v4u*)(b_ + RAW_OFF(rawe1, ch)); rawp[2] = *(const v4u*)(b_ + RAW_OFF(rawe2, ch)); \
        av = *(const float*)((const char*)ACLC + (size_t)(((seq0 >> 7) + (ch)) * 32 + combo) * 512 + voA); } while (0)
#define RAW_ST(e_, ch, val) do { const int r_ = (e_) >> 2, p2_ = (ch) * 128 + r_ - 2; const v4u z_ = {0u, 0u, 0u, 0u}; *(LAS v4u*)(L + SC_RAW + r_ * 64 + ((e_) & 3) * 16) = (p2_ < 0 || p2_ >= S) ? z_ : (val); } while (0)
#define STORE_RAW(ch) do { RAW_ST(tq, ch, rawp[0]); RAW_ST(rawe1, ch, rawp[1]); RAW_ST(rawe2, ch, rawp[2]); } while (0)
    float av0;
    { const int ch0 = dir ? NC - 1 : 0, ch1 = dir ? NC - 2 : 1; LOAD_XR(ch0); STORE_RAW(ch0); av0 = av; LOAD_XR(ch1); LOAD_CF(ch0); LOAD_GF(ch0); LOAD_BF(ch0); }
    __syncthreads();
    for (int step = 0; step < NC; ++step) {
        const int chunk = dir ? NC - 1 - step : step, row0 = seq0 + chunk * 128, par = step & 1;
        int chn = dir ? chunk - 1 : chunk + 1; chn = chn < 0 ? 0 : (chn >= NC ? NC - 1 : chn);
        int chn2 = dir ? chunk - 2 : chunk + 2; chn2 = chn2 < 0 ? 0 : (chn2 >= NC ? NC - 1 : chn2);
        LAS float* ACL = (LAS float*)(L + SC_ACL) + par * 128; LAS float* DTV = (LAS float*)(L + SC_DTV) + par * 128;
        float xc[8][2];
        { unsigned rw[12]; float cwt[5][2], cbias[2];
#pragma unroll
          for (int j = 0; j < 5; ++j) { const f32x2_t w2 = *(const LAS f32x2_t*)(L + SC_CW + (j * 32 + 2 * cp) * 4); cwt[j][0] = w2.x; cwt[j][1] = w2.y; }
          { const f32x2_t w2 = *(const LAS f32x2_t*)(L + SC_CW + (160 + 2 * cp) * 4); cbias[0] = w2.x; cbias[1] = w2.y; }
#pragma unroll
          for (int i = 0; i < 12; ++i) rw[i] = *(const LAS unsigned*)(L + SC_RAW + (8 * tg + i) * 64 + cp * 4);
#pragma unroll
          for (int t = 0; t < 8; ++t) { float x0 = cbias[0], x1 = cbias[1];
#pragma unroll
              for (int j = 0; j < 5; ++j) { x0 += cwt[j][0] * bflo(rw[t + j]); x1 += cwt[j][1] * bfhi(rw[t + j]); }
              xc[t][0] = silu_f(x0); xc[t][1] = silu_f(x1); }
          if (tq < 128) ACL[tq] = av0; else DTV[tq - 128] = av0; }
        __syncthreads();
        const float tot = dir ? ACL[0] : ACL[127];
        const size_t orow = (size_t)(row0 + lrow); const bool fin = step >= NC / 2;
        const unsigned voP = (unsigned)(lrow * 1024 + chb + 4 * h) * 2u, voZ = (unsigned)(lrow * 2048 + chb + 4 * h) * 2u;
        char* pbase = (char*)PART + (size_t)row0 * 2048; char* zbase = (char*)F.MIX + (size_t)row0 * 4096;
        v2u pv4[4], zv4[4];
        {
#pragma unroll
            for (int t = 0; t < 8; ++t) { const int tk = 8 * tg + t; const float dt = DTV[tk]; const float wsc = dt * __builtin_amdgcn_exp2f(tot - ACL[tk]);
                *(LAS unsigned*)(L + SC_XC + tk * 64 + cp * 4) = cvtpk(xc[t][0], xc[t][1]);
                *(LAS unsigned*)(L + SC_XDT + tk * 64 + cp * 4) = cvtpk(xc[t][0] * dt, xc[t][1] * dt);
                *(LAS unsigned*)(L + SC_XW + tk * 64 + cp * 4) = cvtpk(xc[t][0] * wsc, xc[t][1] * wsc); }
#pragma unroll
            for (int gq = 0; gq < 4; ++gq) { v2u pv; pv.x = cvtpk(accS[4 * gq], accS[4 * gq + 1]); pv.y = cvtpk(accS[4 * gq + 2], accS[4 * gq + 3]); *(LAS v2u*)(L + SC_SB + lrow * 64 + (8 * gq + 4 * h) * 2) = pv; }
            if (fin) {
#pragma unroll
                for (int gq = 0; gq < 4; ++gq) { pv4[gq] = *(const v2u*)(pbase + voP + 16 * gq); zv4[gq] = *(const v2u*)(zbase + voZ + 16 * gq); } }
            STORE_RAW(chn); av0 = av; LOAD_XR(chn2);
        }
        __syncthreads();
        f32x16 accY;
#pragma unroll
        for (int i = 0; i < 16; ++i) accY[i] = 0.f;
#pragma unroll
        for (int st = 0; st < 8; ++st) { LAS const unsigned char* ap = L + SC_SB + 16 * st * 64 + vt_off; const s16x4 lo = vtr(ap), hi = vtr(ap + 4 * 64);
            accY = MFMA32(__builtin_shufflevector(lo, hi, 0, 1, 2, 3, 4, 5, 6, 7), Cf[st], accY); }
        SCHED_FENCE(); LOAD_CF(chn); SCHED_FENCE();
        const float acl_l = ACL[lrow];
        { const float sc = __builtin_amdgcn_exp2f(acl_l);
#pragma unroll
          for (int i = 0; i < 16; ++i) accY[i] *= sc; }
        int lim0 = c - 8 * h; asm volatile("" : "+v"(lim0));
        const int sgn = dir ? 1 : -1;
#pragma unroll
        for (int sb = 0; sb < 4; ++sb) { const bool need = dir ? (sb >= wq) : (sb <= wq);
            if (need) {
#pragma unroll
                for (int st = 0; st < 2; ++st) { const int s0 = 32 * sb + 16 * st + 8 * h;
                    const f32x4 e0 = *(const LAS f32x4*)(ACL + s0), e1 = *(const LAS f32x4*)(ACL + s0 + 4); const v4u cw = __builtin_bit_cast(v4u, Gf[sb][st]);
                    float gv[8]; gv[0] = bflo(cw.x); gv[1] = bfhi(cw.x); gv[2] = bflo(cw.y); gv[3] = bfhi(cw.y); gv[4] = bflo(cw.z); gv[5] = bfhi(cw.z); gv[6] = bflo(cw.w); gv[7] = bfhi(cw.w);
#pragma unroll
                    for (int j = 0; j < 8; ++j) { const float as = j < 4 ? e0[j] : e1[j - 4]; gv[j] *= __builtin_amdgcn_exp2f(acl_l - as); }
                    if (sb == wq) { const int lim = lim0 - 16 * st;
#pragma unroll
                        for (int j = 0; j < 8; ++j) gv[j] = (sgn * (j - lim) >= 0) ? gv[j] : 0.f; }
                    v4u gw; gw.x = cvtpk(gv[0], gv[1]); gw.y = cvtpk(gv[2], gv[3]); gw.z = cvtpk(gv[4], gv[5]); gw.w = cvtpk(gv[6], gv[7]);
                    LAS const unsigned char* ap = L + SC_XDT + (32 * sb + 16 * st) * 64 + vt_off; const s16x4 lo = vtr(ap), hi = vtr(ap + 4 * 64);
                    accY = MFMA32(__builtin_shufflevector(lo, hi, 0, 1, 2, 3, 4, 5, 6, 7), __builtin_bit_cast(bf16x8, gw), accY); } } }
        SCHED_FENCE(); LOAD_GF(chn); SCHED_FENCE();
        { const float dsc = __builtin_amdgcn_exp2f(tot);
#pragma unroll
          for (int i = 0; i < 16; ++i) accS[i] *= dsc; }
#pragma unroll
        for (int st = 0; st < 8; ++st) { LAS const unsigned char* ap = L + SC_XW + 16 * st * 64 + vt_off; const s16x4 lo = vtr(ap), hi = vtr(ap + 4 * 64);
            accS = MFMA32(__builtin_shufflevector(lo, hi, 0, 1, 2, 3, 4, 5, 6, 7), Bf[st], accS); }
        SCHED_FENCE(); LOAD_BF(chn); SCHED_FENCE();
        if (!fin) {
#pragma unroll
            for (int gq = 0; gq < 4; ++gq) { v2u pv; pv.x = cvtpk(accY[4 * gq], accY[4 * gq + 1]); pv.y = cvtpk(accY[4 * gq + 2], accY[4 * gq + 3]); *(v2u*)(pbase + voP + 16 * gq) = pv; }
        } else {
            float ss = 0.f;
#pragma unroll
            for (int gq = 0; gq < 4; ++gq) { const v2u pv = pv4[gq], zv = zv4[gq]; const v2u xv = *(const LAS v2u*)(L + SC_XC + lrow * 64 + (8 * gq + 4 * h) * 2);
                const float y0 = (accY[4 * gq] + bflo(pv.x) + Dh * bflo(xv.x)) * silu_f(bflo(zv.x)), y1 = (accY[4 * gq + 1] + bfhi(pv.x) + Dh * bfhi(xv.x)) * silu_f(bfhi(zv.x));
                const float y2 = (accY[4 * gq + 2] + bflo(pv.y) + Dh * bflo(xv.y)) * silu_f(bflo(zv.y)), y3 = (accY[4 * gq + 3] + bfhi(pv.y) + Dh * bfhi(xv.y)) * silu_f(bfhi(zv.y));
                ss += (y0 * y0 + y1 * y1) + (y2 * y2 + y3 * y3); v2u ov; ov.x = cvtpk(y0, y1); ov.y = cvtpk(y2, y3); *(v2u*)(zbase + voZ + 16 * gq) = ov; }
            ss += __shfl_xor(ss, 32);
            if (h == 0) atomicAdd(F.SSQ_SSD + orow, ss);
        }
    }
#undef LOAD_CF
#undef LOAD_BF
#undef LOAD_GF
#undef LOAD_XR
#undef STORE_RAW
#undef RAW_ST
#undef RAW_OFF
}
#ifndef MK_ONE_LAUNCH
#define MK_ONE_LAUNCH 1
#endif
constexpr int NPHASE = 8;
__global__ void __launch_bounds__(NT, 2) hybrid_fwd(Args args) {
    extern __shared__ __attribute__((aligned(16))) unsigned char lds[];
    Frame F;
    F.lds = (LAS unsigned char*)lds; F.tid = threadIdx.x; F.lane = F.tid & 63; F.wave = __builtin_amdgcn_readfirstlane(F.tid >> 6); F.G = gridDim.x; F.bid = blockIdx.x;
    F.xp = args.in[0]; F.xsm = args.in[1]; F.w_in = args.in[2]; F.conv_w = args.in[3]; F.conv_b = args.in[4]; F.dtb_f = args.in[5]; F.dtb_b = args.in[6];
    F.alog_f = args.in[7]; F.alog_b = args.in[8]; F.dskip = args.in[9]; F.norm_ssd = args.in[10]; F.norm_in = args.in[11]; F.w_out = args.in[12]; F.norm_f = args.in[13];
    F.out = args.out; F.ws = args.ws; unsigned char* ws = args.ws;
    F.WIN = (bf16*)(ws + WS_WIN); F.WOUT = (bf16*)(ws + WS_WOUT); F.ROPE = (float*)(ws + WS_ROPE); F.DT = (float*)(ws + WS_DT); F.MIX = (bf16*)(ws + WS_MIX);
    F.KB = (bf16*)(ws + WS_K); F.VB = (bf16*)(ws + WS_V); F.ZA = (bf16*)(ws + WS_ZA); F.XS = (bf16*)(ws + WS_XS); F.BCR = (bf16*)(ws + WS_BCR);
    F.XN = (bf16*)args.out;
    F.XC = (bf16*)args.out; F.YF = (bf16*)(ws + WS_FREE);
    F.SSQ_SSD = (float*)(ws + WS_CTL + CTL_SSQ_SSD); F.SSQ_OUT = (float*)(ws + WS_CTL + CTL_SSQ_OUT);
    for (int u = F.tid; u < (LDS_BYTES - LDSCTL_OFF) / 4; u += NT) ((LAS unsigned*)(F.lds + LDSCTL_OFF))[u] = 0u;
    __syncthreads();
    XcdBarrier bar; bar.bar = (unsigned*)(ws + WS_CTL) + CW_BAR; bar.x = 0; bar.st = nullptr;
    if (MK_ONE_LAUNCH) bar = xcd_barrier_post((unsigned*)(ws + WS_CTL) + CW_BAR, (volatile LAS unsigned*)(F.lds + MISC_OFF) + 8);
    const int lo = args.ph_lo, hi = args.ph_hi;
#define IN(k) (lo <= (k) && (k) < hi)
#ifndef PROBE_PHASE
#define PROBE_PHASE -1
#endif
#ifndef PROBE_MULT
#define PROBE_MULT 4
#endif
    volatile LAS unsigned long long* tsl = (volatile LAS unsigned long long*)(F.lds + MISC_OFF + 128);
#define STAMP(k) do { if (PROBE_PHASE >= 0 && F.bid == 0 && F.tid == 0) tsl[(k)] = __builtin_amdgcn_s_memrealtime(); } while (0)
#define SEAM(k) do { if (IN(k) && IN((k) + 1)) xcd_barrier(bar); STAMP((k) + 1); } while (0)
    STAMP(0);
    if (IN(0)) { p0_prologue(F); SEAM(0); }
    if (IN(1)) {
        pg8::Gemm g{F.XN, F.WIN, M, NPAD, DM}; pg8::StaticOrder S; S.init(M, NPAD, F.G, F.bid);
        pg8::EpiInProj E{F.MIX, F.KB, F.VB, F.ZA, F.XS, F.BCR, F.DT, F.ROPE};
        pg8::gemm_phase<pg8::EpiInProj, pg8::StaticOrder, true, true>(F.lds + RING_OFF, g, S, E);
        SEAM(1);
    }
    bf16* OST = (bf16*)(ws + WS_FREE); float* LST = (float*)(ws + WS_FREE + 96 * MiB);
    bf16* PART = (bf16*)args.out; bf16* CC = (bf16*)((unsigned char*)args.out + 96 * MiB); bf16* BT = (bf16*)((unsigned char*)args.out + 120 * MiB); bf16* CBm = (bf16*)((unsigned char*)args.out + 144 * MiB);
    float* ACLC = (float*)((unsigned char*)args.out + 168 * MiB); float* DTC = ACLC + 2097152;
    if (IN(2)) { for (int it = F.bid; it < 768; it += F.G) ssd_pre_item(F, it, CC, BT, CBm, DTC, ACLC);
                 attn_phase<16, 0, false>(F, OST, LST, nullptr); SEAM(2); }
    if (IN(3)) { attn_phase<4, 1, false>(F, OST, LST, nullptr); SEAM(3); }
    if (IN(4)) {
        for (int it = F.bid; it < 256; it += F.G) ssd_chain_item(F, it, CC, BT, CBm, DTC, ACLC, PART);
        attn_phase<1, 2, true>(F, OST, LST, (unsigned*)(ws + WS_CTL) + CW_QCTR);
        SEAM(4);
    }
    if (IN(5)) { nv_ssd_norm(F); SEAM(5); }
    if (IN(6)) {
        pg8::Gemm g{F.MIX, F.WOUT, M, DM, KOUT}; pg8::StaticOrder S; S.init(M, DM, F.G, F.bid);
        pg8::EpiOutProj E{F.xp, F.xsm, F.out, F.SSQ_OUT};
        pg8::gemm_phase<pg8::EpiOutProj, pg8::StaticOrder, true, true>(F.lds + RING_OFF, g, S, E);
        SEAM(6);
    }
    if (IN(7)) final_norm(F);
    if (PROBE_PHASE >= 0 && F.bid == 0 && F.tid == 0) {
        if (PROBE_PHASE == 7) tsl[8] = __builtin_amdgcn_s_memrealtime();
        const unsigned long long T = (tsl[PROBE_PHASE + 1] - tsl[PROBE_PHASE]) * PROBE_MULT, t0 = __builtin_amdgcn_s_memrealtime();
        while (__builtin_amdgcn_s_memrealtime() - t0 < T) __builtin_amdgcn_s_sleep(32);
    }
#undef IN
#undef SEAM
}
extern "C" void kernel_launch(void* const* d_in, const int* in_sizes, int n_in, void* d_out, int out_size, void* d_ws, size_t ws_size, hipStream_t stream) {
    static int grid = 0;
    if (grid == 0) {
        if (n_in != 14 || out_size != M * DM || ws_size < WS_END) { fprintf(stderr, "kernel_launch: unexpected problem: n_in %d out %d ws %zu\n", n_in, out_size, ws_size); grid = -1; return; }
        int dev = 0, cus = 0, per_cu = 0;
        if (hipGetDevice(&dev) != hipSuccess || hipDeviceGetAttribute(&cus, hipDeviceAttributeMultiprocessorCount, dev) != hipSuccess) { grid = -1; return; }
        if (hipFuncSetAttribute((const void*)hybrid_fwd, hipFuncAttributeMaxDynamicSharedMemorySize, LDS_BYTES) != hipSuccess) { fprintf(stderr, "kernel_launch: hipFuncSetAttribute failed\n"); grid = -1; return; }
        if (hipOccupancyMaxActiveBlocksPerMultiprocessor(&per_cu, (const void*)hybrid_fwd, NT, LDS_BYTES) != hipSuccess || per_cu < 1) { fprintf(stderr, "kernel_launch: occupancy query says %d\n", per_cu); per_cu = 1; }
        (void)hipGetLastError();
        grid = cus;
    }
    if (grid < 0) return;
    (void)hipMemsetAsync((char*)d_ws + WS_CTL, 0, CTL_ZERO_BYTES, stream);
    Args a{};
    for (int i = 0; i < 14; ++i) a.in[i] = (const float*)d_in[i];
    a.out = (float*)d_out; a.ws = (unsigned char*)d_ws;
#if MK_ONE_LAUNCH
    a.ph_lo = 0; a.ph_hi = NPHASE;
    hipLaunchKernelGGL(hybrid_fwd, dim3(grid), dim3(NT), LDS_BYTES, stream, a);
#else
    for (int p = 0; p < NPHASE; ++p) { a.ph_lo = p; a.ph_hi = p + 1; hipLaunchKernelGGL(hybrid_fwd, dim3(grid), dim3(NT), LDS_BYTES, stream, a); }
#endif
}
```
